# Optimizing an MI355X kernel written in HIP

```python
import jax, jax.numpy as jnp
from jax import lax
import numpy as np

D_MODEL = 1024
BATCH = 4
SEQ = 4096
DEPTH = 1

MEM_LEN = 256
HG_HEADS = 4
HG_DK = 128
HG_DV = 128
HG_WIDTH = HG_HEADS * HG_DV
HG_CHUNK = 64
SG_GROUPS = 4
SG_DIM = 128
SG_WIDTH = SG_GROUPS * SG_DIM
SG_CHUNK = 128
MIX_WIDTH = HG_WIDTH + SG_WIDTH
IN_WIDTH = 4 * HG_WIDTH + 2 * SG_WIDTH
X_HEADS = 4
X_HEAD_DIM = D_MODEL // X_HEADS
D_FF = 2816
ALPHA = (2.0 * DEPTH) ** 0.25
BETA = (8.0 * DEPTH) ** -0.25
LN_EPS = 1e-5

kernel_name = "hybrid_hgrn2_sgu_macaron_deepnorm"


def _layer_norm(x, g, b):
    xf = x.astype(jnp.float32)
    mu = jnp.mean(xf, axis=-1, keepdims=True)
    var = jnp.mean(jnp.square(xf - mu), axis=-1, keepdims=True)
    return ((xf - mu) * lax.rsqrt(var + LN_EPS) * g + b).astype(x.dtype)


def _rms_norm(x, g):
    xf = x.astype(jnp.float32)
    return xf * lax.rsqrt(jnp.mean(jnp.square(xf), axis=-1, keepdims=True) + LN_EPS) * g


def _swiglu(x, w_gate, w_up, w_down):
    return (jax.nn.silu(x @ w_gate) * (x @ w_up)) @ w_down


def _hgrn2(q, fz, iv, lb):
    B, T, H, DK = q.shape
    DV = iv.shape[-1]
    n_chunks = T // HG_CHUNK
    q = q.astype(jnp.float32)
    fz = fz.astype(jnp.float32)
    iv = iv.astype(jnp.float32)
    log_f = jnp.log(lb + (1.0 - lb) * jax.nn.sigmoid(fz))
    k = (1.0 - lb) * jax.nn.sigmoid(-fz)

    def chunks(a):
        return a.reshape(B, n_chunks, HG_CHUNK, H, a.shape[-1]).transpose(1, 0, 3, 2, 4)

    causal = jnp.tril(jnp.ones((HG_CHUNK, HG_CHUNK), dtype=bool))[:, :, None]

    def step(S, inp):
        qc, kc, vc, lfc = inp
        b = jnp.cumsum(lfc, axis=2)
        diff = b[:, :, :, None, :] - b[:, :, None, :, :]
        decay = jnp.where(causal, jnp.exp(jnp.where(causal, diff, 0.0)), 0.0)
        scores = jnp.einsum('bhtd,bhsd,bhtsd->bhts', qc, kc, decay)
        o = (jnp.einsum('bhts,bhsv->bhtv', scores, vc)
             + jnp.einsum('bhtd,bhdv->bhtv', qc * jnp.exp(b), S))
        b_end = b[:, :, -1:, :]
        S = (jnp.exp(b_end[:, :, 0, :])[..., None] * S
             + jnp.einsum('bhsd,bhsv->bhdv', kc * jnp.exp(b_end - b), vc))
        return S, o

    S0 = jnp.zeros((B, H, DK, DV), jnp.float32)
    _, o = lax.scan(step, S0, (chunks(q), chunks(k), chunks(iv), chunks(log_f)))
    return o.transpose(1, 0, 3, 2, 4).reshape(B, T, H, DV)


def _spatial_gating(uv, w_s, b_s, ln_g, ln_b):
    B, T, _ = uv.shape
    u, v = jnp.split(uv, 2, axis=-1)
    v = _layer_norm(v.reshape(B, T, SG_GROUPS, SG_DIM), ln_g, ln_b)
    v = v.reshape(B, T // SG_CHUNK, SG_CHUNK, SG_GROUPS, SG_DIM)
    causal = jnp.tril(jnp.ones((SG_CHUNK, SG_CHUNK), dtype=bool))
    w = jnp.where(causal, w_s, 0.0)
    s = jnp.einsum('gts,bnsgc->bntgc', w, v) + b_s.T[None, None, :, :, None]
    return u * s.reshape(B, T, SG_WIDTH)


def _token_mixers(h, w_in, lb, hg_norm_g, sg_ln_g, sg_ln_b, sg_w_s, sg_b_s, w_out):
    B, T, _ = h.shape
    proj = h @ w_in
    q, fz, iv, g, uv = jnp.split(
        proj, [HG_WIDTH, 2 * HG_WIDTH, 3 * HG_WIDTH, 4 * HG_WIDTH], axis=-1)
    heads = lambda a: a.reshape(B, T, HG_HEADS, -1)
    o = _hgrn2(heads(q), heads(fz), heads(iv), lb)
    o = _rms_norm(o, hg_norm_g) * jax.nn.silu(heads(g).astype(jnp.float32))
    o_a = o.reshape(B, T, HG_WIDTH).astype(h.dtype)
    o_b = _spatial_gating(jax.nn.gelu(uv), sg_w_s, sg_b_s, sg_ln_g, sg_ln_b)
    return jnp.concatenate([o_a, o_b], axis=-1) @ w_out


def _memory_cross_attention(h, mem, mem_g, mem_b, wq, wk, wv, wo):
    B, T, _ = h.shape
    M = mem.shape[1]
    m = _layer_norm(mem, mem_g, mem_b)
    q = (h @ wq).reshape(B, T, X_HEADS, X_HEAD_DIM)
    k = (m @ wk).reshape(B, M, X_HEADS, X_HEAD_DIM)
    v = (m @ wv).reshape(B, M, X_HEADS, X_HEAD_DIM)
    s = jnp.einsum('bthd,bmhd->bhtm', q.astype(jnp.float32), k.astype(jnp.float32)) * (X_HEAD_DIM ** -0.5)
    p = jax.nn.softmax(s, axis=-1).astype(h.dtype)
    o = jnp.einsum('bhtm,bmhd->bthd', p, v).reshape(B, T, D_MODEL)
    return o @ wo


def setup_inputs(seed: int = 0) -> dict:
    key = jax.random.key(seed)
    ks = iter(jax.random.split(key, 48))
    L = DEPTH

    def nrm(shape, scale):
        return jax.random.normal(next(ks), shape, jnp.float32) * scale

    def gain(shape):
        return 1.0 + nrm(shape, 0.05)

    def bias(shape):
        return nrm(shape, 0.01)

    d_in = D_MODEL ** -0.5
    f_in = D_FF ** -0.5
    return {
        "x": nrm((BATCH, SEQ, D_MODEL), 1.0),
        "mem": nrm((BATCH, MEM_LEN, D_MODEL), 1.0),
        "ffn1_w_gate": nrm((L, D_MODEL, D_FF), d_in),
        "ffn1_w_up": nrm((L, D_MODEL, D_FF), d_in),
        "ffn1_w_down": nrm((L, D_FF, D_MODEL), f_in * BETA),
        "ln1_g": gain((L, D_MODEL)),
        "ln1_b": bias((L, D_MODEL)),
        "w_in": nrm((L, D_MODEL, IN_WIDTH), d_in),
        "hg_lb_logits": nrm((DEPTH + 1, HG_HEADS, HG_DK), 0.5),
        "hg_norm_g": gain((L, HG_DV)),
        "sg_ln_g": gain((L, SG_GROUPS, SG_DIM)),
        "sg_ln_b": bias((L, SG_GROUPS, SG_DIM)),
        "sg_w_s": nrm((L, SG_GROUPS, SG_CHUNK, SG_CHUNK), SG_CHUNK ** -0.5),
        "sg_b_s": gain((L, SG_GROUPS, SG_CHUNK)),
        "w_out": nrm((L, MIX_WIDTH, D_MODEL), (MIX_WIDTH ** -0.5) * BETA),
        "ln2_g": gain((L, D_MODEL)),
        "ln2_b": bias((L, D_MODEL)),
        "mem_ln_g": gain((L, D_MODEL)),
        "mem_ln_b": bias((L, D_MODEL)),
        "xa_w_q": nrm((L, D_MODEL, D_MODEL), d_in),
        "xa_w_k": nrm((L, D_MODEL, D_MODEL), d_in),
        "xa_w_v": nrm((L, D_MODEL, D_MODEL), d_in * BETA),
        "xa_w_o": nrm((L, D_MODEL, D_MODEL), d_in * BETA),
        "ln3_g": gain((L, D_MODEL)),
        "ln3_b": bias((L, D_MODEL)),
        "ffn2_w_gate": nrm((L, D_MODEL, D_FF), d_in),
        "ffn2_w_up": nrm((L, D_MODEL, D_FF), d_in),
        "ffn2_w_down": nrm((L, D_FF, D_MODEL), f_in * BETA),
        "ln4_g": gain((L, D_MODEL)),
        "ln4_b": bias((L, D_MODEL)),
    }


def reference(x, mem, ffn1_w_gate, ffn1_w_up, ffn1_w_down, ln1_g, ln1_b,
              w_in, hg_lb_logits, hg_norm_g, sg_ln_g, sg_ln_b, sg_w_s, sg_b_s,
              w_out, ln2_g, ln2_b, mem_ln_g, mem_ln_b, xa_w_q, xa_w_k, xa_w_v,
              xa_w_o, ln3_g, ln3_b, ffn2_w_gate, ffn2_w_up, ffn2_w_down,
              ln4_g, ln4_b):
    lower_bounds = jnp.cumsum(jax.nn.softmax(hg_lb_logits.astype(jnp.float32), axis=0), axis=0)
    h = x
    for l in range(DEPTH):
        h = _layer_norm(ALPHA * h + 0.5 * _swiglu(h, ffn1_w_gate[l], ffn1_w_up[l], ffn1_w_down[l]),
                        ln1_g[l], ln1_b[l])
        mix = _token_mixers(h, w_in[l], lower_bounds[l], hg_norm_g[l], sg_ln_g[l], sg_ln_b[l],
                            sg_w_s[l], sg_b_s[l], w_out[l])
        h = _layer_norm(ALPHA * h + mix, ln2_g[l], ln2_b[l])
        xa = _memory_cross_attention(h, mem, mem_ln_g[l], mem_ln_b[l], xa_w_q[l], xa_w_k[l],
                                     xa_w_v[l], xa_w_o[l])
        h = _layer_norm(ALPHA * h + xa, ln3_g[l], ln3_b[l])
        h = _layer_norm(ALPHA * h + 0.5 * _swiglu(h, ffn2_w_gate[l], ffn2_w_up[l], ffn2_w_down[l]),
                        ln4_g[l], ln4_b[l])
    return h
```

```cpp
#include <hip/hip_runtime.h>
#include <cstdio>
#include <cstdint>
namespace pg8 {
#define PG8_LAS __attribute__((address_space(3)))
typedef unsigned short bf16_t;
typedef short bf16x8 __attribute__((ext_vector_type(8)));
typedef float f32x4 __attribute__((ext_vector_type(4)));
typedef float f32x2 __attribute__((ext_vector_type(2)));
typedef unsigned u32x4 __attribute__((ext_vector_type(4)));
typedef unsigned u32x2 __attribute__((ext_vector_type(2)));
constexpr int BM = 256, BK = 64, HALF = 128, HTB = HALF * BK * 2, STAGE_BYTES = 8 * HTB, NXCD = 8, WGM = 8;

__host__ __device__ __forceinline__ int lds_byte(int r, int c) { const int st = (r >> 4) * 2 + (c >> 5), rr = r & 15, cc = c & 31, ob = rr * 64 + cc * 2; return st * 1024 + (ob ^ (((ob >> 9) & 1) << 5)); }
__host__ __device__ __forceinline__ void stage_rc(int b, int& R, int& C) { const int st = b / 1024, sb = b % 1024, swz = sb ^ (((sb >> 9) & 1) << 5); R = (st >> 1) * 16 + swz / 64; C = (st & 1) * 32 + (swz % 64) / 2; }
__host__ __device__ __forceinline__ int perm32(int rho) { const int n = rho >> 4, i = rho & 15; return 8 * (i >> 2) + 4 * n + (i & 3); }

struct Unit { int pm, pn; unsigned aoff, boff; };
struct Gemm { const bf16_t* A; const bf16_t* Bt; int lda, ldb, K; };

struct GridOrder {
    int nM, nN, nwg, G, c; unsigned astep, bstep;
    __device__ void init(int M, int N, int lda, int ldb, int G_, int c_) { nM = M / BM; nN = N / BM; nwg = nM * nN; G = G_; c = c_; astep = (unsigned)(BM * lda * 2); bstep = (unsigned)(BM * ldb * 2); }
    __device__ bool next(int i, Unit& u) const {
        const long L = (long)i * G + c; if (L >= nwg) return false;
        int wgid = (int)L; { const int q = nwg / NXCD, r = nwg % NXCD, xcd = wgid % NXCD, off = wgid / NXCD; wgid = (xcd < r ? xcd * (q + 1) : r * (q + 1) + (xcd - r) * q) + off; }
        const int nig = WGM * nN, gid = wgid / nig, fm = gid * WGM, gsz = (nM - fm) < WGM ? (nM - fm) : WGM;
        u.pm = fm + ((wgid % nig) % gsz); u.pn = (wgid % nig) / gsz; u.aoff = (unsigned)u.pm * astep; u.boff = (unsigned)u.pn * bstep; return true;
    }
};
struct SmallOrder {
    int nM, nN, c; unsigned astep, bstep;
    __device__ void init(int M, int N, int lda, int ldb, int c_rel) { nM = M / BM; nN = N / BM; c = c_rel; astep = (unsigned)(BM * lda * 2); bstep = (unsigned)(BM * ldb * 2); }
    __device__ bool next(int i, Unit& u) const {
        if (i > 0 || c < 0 || c >= nM * nN) return false;
        u.pm = c / nN; u.pn = c % nN; u.aoff = (unsigned)u.pm * astep; u.boff = (unsigned)u.pn * bstep; return true;
    }
};
struct AttnOrder {
    int c, mode;
    __device__ bool next(int i, Unit& u) const {
        if (i > 0 || c >= 256) return false;
        const int x = c & 7, j = c >> 3, bh = 2 * x + (j >> 4), qb = j & 15, b = bh >> 2, h = bh & 3;
        u.pm = b * 16 + qb; u.pn = h;
        u.aoff = (unsigned)(((size_t)u.pm * 256 * 1024 + h * 256) * 2);
        u.boff = mode == 0 ? (unsigned)(((size_t)b * 256 * 1024 + h * 256) * 2) : (unsigned)(((size_t)h * 256 * 1024 + b * 256) * 2);
        return true;
    }
};

__device__ __forceinline__ unsigned cvt_pk_bf16(float lo, float hi) { unsigned r; asm volatile("v_cvt_pk_bf16_f32 %0, %1, %2" : "=v"(r) : "v"(lo), "v"(hi)); return r; }
__device__ __forceinline__ float fast_rcp(float x) { return __builtin_amdgcn_rcpf(x); }
__device__ __forceinline__ float silu_f(float x) { return x * fast_rcp(1.0f + __expf(-x)); }
__device__ __forceinline__ float gelu_tanh_f(float x) { const float u = 1.5957691216f * (x + 0.044715f * x * x * x); return x * fast_rcp(1.0f + __expf(-u)); }

template <int ACT  > struct EpiBf16 {
    static constexpr bool PERM = true, AFTER_DRAIN = false;
    bf16_t* O; int ldc; float scale;
    __device__ __forceinline__ void operator()(const f32x4 (&acc)[2][2][4][2], const Unit& u, int wr, int wc, int fr, int fq) const {
        const int row0 = u.pm * BM + wr * 64 + fr, col0 = u.pn * BM + wc * 32 + 8 * fq;
#pragma unroll
        for (int ai = 0; ai < 2; ++ai)
#pragma unroll
            for (int m = 0; m < 4; ++m) { bf16_t* rowp = O + (size_t)(row0 + ai * HALF + m * 16) * ldc + col0;
#pragma unroll
                for (int bj = 0; bj < 2; ++bj) { f32x4 v0 = acc[ai][bj][m][0], v1 = acc[ai][bj][m][1];
                    if (ACT == 1) { for (int j = 0; j < 4; ++j) { v0[j] = silu_f(v0[j]); v1[j] = silu_f(v1[j]); } }
                    if (ACT == 2) { for (int j = 0; j < 4; ++j) { v0[j] = gelu_tanh_f(v0[j]); v1[j] = gelu_tanh_f(v1[j]); } }
                    v0 = v0 * scale; v1 = v1 * scale; u32x4 w; w.x = cvt_pk_bf16(v0[0], v0[1]); w.y = cvt_pk_bf16(v0[2], v0[3]); w.z = cvt_pk_bf16(v1[0], v1[1]); w.w = cvt_pk_bf16(v1[2], v1[3]);
                    *(u32x4*)(rowp + bj * HALF) = w; } }
    }
};
struct EpiSwiglu {
    static constexpr bool PERM = true, AFTER_DRAIN = false;
    bf16_t* O; int ldc;
    __device__ __forceinline__ void operator()(const f32x4 (&acc)[2][2][4][2], const Unit& u, int wr, int wc, int fr, int fq) const {
        const int row0 = u.pm * BM + wr * 64 + fr, col0 = u.pn * HALF + wc * 32 + 8 * fq;
#pragma unroll
        for (int ai = 0; ai < 2; ++ai)
#pragma unroll
            for (int m = 0; m < 4; ++m) { bf16_t* rowp = O + (size_t)(row0 + ai * HALF + m * 16) * ldc + col0;
                f32x4 g0 = acc[ai][0][m][0], g1 = acc[ai][0][m][1]; const f32x4 u0 = acc[ai][1][m][0], u1 = acc[ai][1][m][1];
#pragma unroll
                for (int j = 0; j < 4; ++j) { g0[j] = silu_f(g0[j]) * u0[j]; g1[j] = silu_f(g1[j]) * u1[j]; }
                u32x4 w; w.x = cvt_pk_bf16(g0[0], g0[1]); w.y = cvt_pk_bf16(g0[2], g0[3]); w.z = cvt_pk_bf16(g1[0], g1[1]); w.w = cvt_pk_bf16(g1[2], g1[3]);
                *(u32x4*)rowp = w; }
    }
};
struct EpiResid {
    static constexpr bool PERM = true, AFTER_DRAIN = false;
    const float* base; float* out; float alpha, scale;
    __device__ __forceinline__ void operator()(const f32x4 (&acc)[2][2][4][2], const Unit& u, int wr, int wc, int fr, int fq) const {
        const int row0 = u.pm * BM + wr * 64 + fr, col0 = u.pn * BM + wc * 32 + 8 * fq;
#pragma unroll
        for (int ai = 0; ai < 2; ++ai)
#pragma unroll
            for (int m = 0; m < 4; ++m) { const size_t off = (size_t)(row0 + ai * HALF + m * 16) * 1024 + col0;
#pragma unroll
                for (int bj = 0; bj < 2; ++bj) {
                    const f32x4 b0 = *(const f32x4*)(base + off + bj * HALF), b1 = *(const f32x4*)(base + off + bj * HALF + 4);
                    *(f32x4*)(out + off + bj * HALF) = b0 * alpha + acc[ai][bj][m][0] * scale;
                    *(f32x4*)(out + off + bj * HALF + 4) = b1 * alpha + acc[ai][bj][m][1] * scale; } }
    }
};
template <long GOFF, long UOFF> struct EpiProj {
    static constexpr bool PERM = true, AFTER_DRAIN = false;
    bf16_t* Q; float* FZ;
    __device__ __forceinline__ void operator()(const f32x4 (&acc)[2][2][4][2], const Unit& u, int wr, int wc, int fr, int fq) const {
        const int seg = u.pn >> 1; const int row0 = u.pm * BM + wr * 64 + fr, col0 = (u.pn & 1) * BM + wc * 32 + 8 * fq;
        const long doff = seg == 2 ? GOFF : (seg == 3 ? UOFF : 0L);
        bf16_t* dst = Q + doff;
#pragma unroll
        for (int ai = 0; ai < 2; ++ai)
#pragma unroll
            for (int m = 0; m < 4; ++m) { const size_t off = (size_t)(row0 + ai * HALF + m * 16) * 512 + col0;
#pragma unroll
                for (int bj = 0; bj < 2; ++bj) { f32x4 v0 = acc[ai][bj][m][0], v1 = acc[ai][bj][m][1];
                    if (seg == 1) { *(f32x4*)(FZ + off + bj * HALF) = v0; *(f32x4*)(FZ + off + bj * HALF + 4) = v1; }
                    else {
                        if (seg == 2) { for (int j = 0; j < 4; ++j) { v0[j] = silu_f(v0[j]); v1[j] = silu_f(v1[j]); } }
                        if (seg == 3) { for (int j = 0; j < 4; ++j) { v0[j] = gelu_tanh_f(v0[j]); v1[j] = gelu_tanh_f(v1[j]); } }
                        u32x4 w; w.x = cvt_pk_bf16(v0[0], v0[1]); w.y = cvt_pk_bf16(v0[2], v0[3]); w.z = cvt_pk_bf16(v1[0], v1[1]); w.w = cvt_pk_bf16(v1[2], v1[3]);
                        *(u32x4*)(dst + off + bj * HALF) = w; } } }
    }
};
template <long VOFF> struct EpiProjT {
    static constexpr bool PERM = true, AFTER_DRAIN = false;
    bf16_t* IVT; int ldc;
    __device__ __forceinline__ void operator()(const f32x4 (&acc)[2][2][4][2], const Unit& u, int wr, int wc, int fr, int fq) const {
        const bool isv = u.pm >= 2; bf16_t* dst = IVT + (isv ? VOFF : 0L);
        const int row0 = (u.pm & 1) * BM + wr * 64 + fr, col0 = u.pn * BM + wc * 32 + 8 * fq;
#pragma unroll
        for (int ai = 0; ai < 2; ++ai)
#pragma unroll
            for (int m = 0; m < 4; ++m) { bf16_t* rowp = dst + (size_t)(row0 + ai * HALF + m * 16) * ldc + col0;
#pragma unroll
                for (int bj = 0; bj < 2; ++bj) { f32x4 v0 = acc[ai][bj][m][0], v1 = acc[ai][bj][m][1];
                    if (isv) { for (int j = 0; j < 4; ++j) { v0[j] = gelu_tanh_f(v0[j]); v1[j] = gelu_tanh_f(v1[j]); } }
                    u32x4 w; w.x = cvt_pk_bf16(v0[0], v0[1]); w.y = cvt_pk_bf16(v0[2], v0[3]); w.z = cvt_pk_bf16(v1[0], v1[1]); w.w = cvt_pk_bf16(v1[2], v1[3]);
                    *(u32x4*)(rowp + bj * HALF) = w; } }
    }
};
struct EpiSoftmax {
    static constexpr bool PERM = true, AFTER_DRAIN = true;
    bf16_t* P; int ldc;
    __device__ __forceinline__ void fused(f32x4 (&acc)[2][2][4][2], const Unit& u, int wr, int wc, int fr, int fq, PG8_LAS unsigned char* lds, int wid, int lane) const {
        PG8_LAS float* X = (PG8_LAS float*)lds;
        PG8_LAS float* Y = (PG8_LAS float*)(lds + 4096);
#pragma unroll
        for (int ai = 0; ai < 2; ++ai)
#pragma unroll
            for (int m = 0; m < 4; ++m) { float mx = -3.0e38f;
#pragma unroll
                for (int bj = 0; bj < 2; ++bj)
#pragma unroll
                    for (int n = 0; n < 2; ++n) { const f32x4 x = acc[ai][bj][m][n]; mx = fmaxf(mx, fmaxf(fmaxf(x[0], x[1]), fmaxf(x[2], x[3]))); }
                mx = fmaxf(mx, __shfl_xor(mx, 16)); mx = fmaxf(mx, __shfl_xor(mx, 32));
                if (fq == 0) X[(ai * HALF + wr * 64 + m * 16 + fr) * 4 + wc] = mx; }
        asm volatile("s_waitcnt lgkmcnt(0)" ::: "memory"); __builtin_amdgcn_s_barrier(); asm volatile("" ::: "memory");
#pragma unroll
        for (int ai = 0; ai < 2; ++ai)
#pragma unroll
            for (int m = 0; m < 4; ++m) { const int r = ai * HALF + wr * 64 + m * 16 + fr; const f32x4 q = *(const PG8_LAS f32x4*)(X + r * 4);
                const float mx = fmaxf(fmaxf(q[0], q[1]), fmaxf(q[2], q[3])); float s = 0.f;
#pragma unroll
                for (int bj = 0; bj < 2; ++bj)
#pragma unroll
                    for (int n = 0; n < 2; ++n) { f32x4 x = acc[ai][bj][m][n];
#pragma unroll
                        for (int j = 0; j < 4; ++j) { x[j] = __expf(x[j] - mx); s += x[j]; }
                        acc[ai][bj][m][n] = x; }
                s += __shfl_xor(s, 16); s += __shfl_xor(s, 32);
                if (fq == 0) Y[r * 4 + wc] = s; }
        asm volatile("s_waitcnt lgkmcnt(0)" ::: "memory"); __builtin_amdgcn_s_barrier(); asm volatile("" ::: "memory");
        const int row0 = u.pm * BM + wr * 64 + fr, col0 = u.pn * BM + wc * 32 + 8 * fq;
#pragma unroll
        for (int ai = 0; ai < 2; ++ai)
#pragma unroll
            for (int m = 0; m < 4; ++m) { const int r = ai * HALF + wr * 64 + m * 16 + fr; const f32x4 q = *(const PG8_LAS f32x4*)(Y + r * 4);
                const float inv = 1.0f / ((q[0] + q[1]) + (q[2] + q[3]));
                bf16_t* rowp = P + (size_t)(row0 + ai * HALF + m * 16) * ldc + col0;
#pragma unroll
                for (int bj = 0; bj < 2; ++bj) { const f32x4 v0 = acc[ai][bj][m][0] * inv, v1 = acc[ai][bj][m][1] * inv;
                    u32x4 w; w.x = cvt_pk_bf16(v0[0], v0[1]); w.y = cvt_pk_bf16(v0[2], v0[3]); w.z = cvt_pk_bf16(v1[0], v1[1]); w.w = cvt_pk_bf16(v1[2], v1[3]);
                    *(u32x4*)(rowp + bj * HALF) = w; } }
        asm volatile("s_waitcnt lgkmcnt(0)" ::: "memory"); __builtin_amdgcn_s_barrier(); asm volatile("" ::: "memory");
    }
};

template <class Epi, class Sched, bool ALIGN_EPI>
__device__ __forceinline__ void gemm_phase(PG8_LAS unsigned char* lds, const Gemm g, const Sched& S, const Epi& E) {
    const int tid = threadIdx.x, wid = __builtin_amdgcn_readfirstlane(tid >> 6), lane = tid & 63, wr = wid >> 2, wc = wid & 3, fr = lane & 15, fq = lane >> 4;
    const int nt = g.K / BK;
    unsigned voffA[2], voffB[2];
#pragma unroll
    for (int i = 0; i < 2; ++i) { int R, C; stage_rc(tid * 16 + i * 8192, R, C); const int Rb = Epi::PERM ? ((R & ~31) + perm32(R & 31)) : R;
        voffA[i] = (unsigned)(R * g.lda + C) * 2u; voffB[i] = (unsigned)(Rb * g.ldb + C) * 2u; }
    const size_t kstep = (size_t)(BK * 2);
    const size_t hstepA = (size_t)HALF * g.lda * 2, hstepB = (size_t)HALF * g.ldb * 2;
    const unsigned ldsw = (unsigned)wid * 1024u;
    const int aoff = lds_byte(wr * 64 + fr, fq * 8), boff = lds_byte(wc * 32 + fr, fq * 8);
#define PG8_SA(b, h) (((b) * 2 + (h)) * HTB)
#define PG8_SB(b, h) ((4 + (b) * 2 + (h)) * HTB)
#define PG8_STAGE(bufoff, gbase, voff) do { _Pragma("unroll") for (int _i = 0; _i < 2; ++_i) \
        __builtin_amdgcn_global_load_lds((const unsigned*)((const char*)(gbase) + (voff)[_i]), (PG8_LAS unsigned*)(lds + (bufoff) + ldsw + _i * 8192), 16, 0, 0); } while (0)
#define PG8_LDA(dst, b, h) do { _Pragma("unroll") for (int m = 0; m < 4; ++m) _Pragma("unroll") for (int k = 0; k < 2; ++k) dst[m][k] = *(const PG8_LAS bf16x8*)(lds + PG8_SA(b, h) + aoff + m * 2048 + k * 1024); } while (0)
#define PG8_LDB(dst, b, h) do { _Pragma("unroll") for (int n = 0; n < 2; ++n) _Pragma("unroll") for (int k = 0; k < 2; ++k) dst[n][k] = *(const PG8_LAS bf16x8*)(lds + PG8_SB(b, h) + boff + n * 2048 + k * 1024); } while (0)
#define PG8_MMA(ai, bj, At, Bt) do { __builtin_amdgcn_s_setprio(1); _Pragma("unroll") for (int m = 0; m < 4; ++m) _Pragma("unroll") for (int n = 0; n < 2; ++n) _Pragma("unroll") for (int k = 0; k < 2; ++k) \
        acc[ai][bj][m][n] = __builtin_amdgcn_mfma_f32_16x16x32_bf16(Bt[n][k], At[m][k], acc[ai][bj][m][n], 0, 0, 0); __builtin_amdgcn_s_setprio(0); } while (0)
#define PG8_WAIT_V(n) asm volatile("s_waitcnt vmcnt(" #n ")" ::: "memory")
#define PG8_WAIT_L(n) asm volatile("s_waitcnt lgkmcnt(" #n ")" ::: "memory")
#define PG8_BAR __builtin_amdgcn_s_barrier()
#define PG8_SCHED __builtin_amdgcn_sched_barrier(0)
    Unit cur, nxt; int ui = 0;
    if (!S.next(0, cur)) return;
    f32x4 acc[2][2][4][2];
#pragma unroll
    for (int a = 0; a < 2; ++a)
#pragma unroll
        for (int b = 0; b < 2; ++b)
#pragma unroll
            for (int m = 0; m < 4; ++m)
#pragma unroll
                for (int n = 0; n < 2; ++n) acc[a][b][m][n] = (f32x4){0.f, 0.f, 0.f, 0.f};
    bf16x8 At[4][2], B0[2][2], B1[2][2];
    const char* cA = (const char*)g.A + cur.aoff; const char* cB = (const char*)g.Bt + cur.boff;
    PG8_STAGE(PG8_SB(0, 0), cB, voffB); PG8_STAGE(PG8_SB(0, 1), cB + hstepB, voffB); PG8_STAGE(PG8_SA(0, 0), cA, voffA); PG8_STAGE(PG8_SA(0, 1), cA + hstepA, voffA);
    if (wr == 1) PG8_BAR;
    PG8_WAIT_V(2); PG8_BAR;
    PG8_STAGE(PG8_SB(1, 0), cB + kstep, voffB); PG8_STAGE(PG8_SA(1, 0), cA + kstep, voffA); PG8_STAGE(PG8_SB(1, 1), cB + hstepB + kstep, voffB);
    PG8_WAIT_V(6); PG8_BAR;
    for (;;) {
        const bool has_next = S.next(ui + 1, nxt);
        const char* nA = has_next ? (const char*)g.A + nxt.aoff : cA; const char* nB = has_next ? (const char*)g.Bt + nxt.boff : cB;
        for (int t = 0; t < nt; t += 2) {
            const bool last = (t == nt - 2);
            const char* a1 = cA + (size_t)(t + 1) * kstep;
            const char* a2 = last ? nA : cA + (size_t)(t + 2) * kstep; const char* b2 = last ? nB : cB + (size_t)(t + 2) * kstep;
            const char* a3 = a2 + kstep; const char* b3 = b2 + kstep;
            PG8_LDB(B0, 0, 0); PG8_LDB(B1, 0, 1); PG8_SCHED; PG8_LDA(At, 0, 0); PG8_STAGE(PG8_SA(1, 1), a1 + hstepA, voffA);
            PG8_WAIT_V(8); PG8_WAIT_L(0); PG8_BAR; PG8_MMA(0, 0, At, B0); PG8_MMA(0, 1, At, B1); PG8_BAR; PG8_SCHED;
            PG8_LDA(At, 0, 1); PG8_STAGE(PG8_SB(0, 0), b2, voffB); PG8_STAGE(PG8_SB(0, 1), b2 + hstepB, voffB); PG8_STAGE(PG8_SA(0, 0), a2, voffA);
            PG8_WAIT_V(8); PG8_WAIT_L(0); PG8_BAR; PG8_MMA(1, 0, At, B0); PG8_MMA(1, 1, At, B1); PG8_BAR; PG8_SCHED;
            PG8_LDB(B0, 1, 0); PG8_LDB(B1, 1, 1); PG8_SCHED; PG8_LDA(At, 1, 0); PG8_STAGE(PG8_SA(0, 1), a2 + hstepA, voffA);
            PG8_WAIT_V(8); PG8_WAIT_L(0); PG8_BAR; PG8_MMA(0, 0, At, B0); PG8_MMA(0, 1, At, B1); PG8_BAR; PG8_SCHED;
            PG8_LDA(At, 1, 1); PG8_STAGE(PG8_SB(1, 0), b3, voffB); PG8_STAGE(PG8_SB(1, 1), b3 + hstepB, voffB); PG8_STAGE(PG8_SA(1, 0), a3, voffA);
            PG8_WAIT_V(8); PG8_WAIT_L(0); PG8_BAR; PG8_MMA(1, 0, At, B0); PG8_MMA(1, 1, At, B1); PG8_BAR; PG8_SCHED;
        }
        if constexpr (ALIGN_EPI) { if (wr == 0) PG8_BAR; }
        if constexpr (!Epi::AFTER_DRAIN) { E(acc, cur, wr, wc, fr, fq); }
        if (!has_next) break;
#pragma unroll
        for (int a = 0; a < 2; ++a)
#pragma unroll
            for (int b = 0; b < 2; ++b)
#pragma unroll
                for (int m = 0; m < 4; ++m)
#pragma unroll
                    for (int n = 0; n < 2; ++n) acc[a][b][m][n] = (f32x4){0.f, 0.f, 0.f, 0.f};
        cur = nxt; cA = nA; cB = nB; ++ui;
        if constexpr (ALIGN_EPI) { if (wr == 1) PG8_BAR; }
    }
    PG8_WAIT_V(0);
    if constexpr (!ALIGN_EPI) { if (wr == 0) PG8_BAR; }
    PG8_BAR;
    if constexpr (Epi::AFTER_DRAIN) { E.fused(acc, cur, wr, wc, fr, fq, lds, wid, lane); }
#undef PG8_SA
#undef PG8_SB
#undef PG8_STAGE
#undef PG8_LDA
#undef PG8_LDB
#undef PG8_MMA
#undef PG8_WAIT_V
#undef PG8_WAIT_L
#undef PG8_BAR
#undef PG8_SCHED
}
}

#define GAS __attribute__((address_space(1)))
#define LAS __attribute__((address_space(3)))
typedef unsigned v4u __attribute__((ext_vector_type(4)));
typedef float f32x4 __attribute__((ext_vector_type(4)));
typedef short bf16x8 __attribute__((ext_vector_type(8)));
#define LDS_WAIT() asm volatile("s_waitcnt lgkmcnt(0)" ::: "memory")
#define VM_WAIT() asm volatile("s_waitcnt vmcnt(0)" ::: "memory")
#define XB_TMO      128
#define XB_XCNT(j)  (256  + 64 * (j))
#define XB_XSUB(j)  (1280 + 64 * (j))
#define XB_XGEN(j)  (2304 + 64 * (j))
#define XB_TOP      3328
#define XB_TOPGEN   3392
#define XCD_BAR_WORDS 3456
#define XB_SPIN_CAP (1u << 18)

__device__ __forceinline__ unsigned xb_ld(unsigned* p)              { return __hip_atomic_load(p, __ATOMIC_RELAXED, __HIP_MEMORY_SCOPE_AGENT); }
__device__ __forceinline__ unsigned xb_add(unsigned* p, unsigned v) { return __hip_atomic_fetch_add(p, v, __ATOMIC_RELAXED, __HIP_MEMORY_SCOPE_AGENT); }
__device__ __forceinline__ unsigned xb_xcc_id() { return (unsigned)__builtin_amdgcn_s_getreg((3 << 11) | 20) & 0xFu; }
#define XB_SPIN(cond, bar) do { unsigned _sp = 0; while (cond) { __builtin_amdgcn_s_sleep(1); \
    if ((++_sp & 255u) == 0u) { if (xb_ld(&(bar)[XB_TMO])) break; if (_sp > XB_SPIN_CAP) { atomicAdd(&(bar)[XB_TMO], 1u); break; } } } } while (0)

struct XcdBarrier {
    unsigned* bar; unsigned x;
    volatile LAS unsigned* st;
};

__device__ __forceinline__ XcdBarrier xcd_barrier_post(unsigned* bar, volatile LAS unsigned* st) {
    XcdBarrier b; b.bar = bar; b.x = xb_xcc_id(); b.st = st;
    if (threadIdx.x == 0) (void)xb_add(&bar[XB_XCNT(b.x)], 1u);
    return b;
}
__device__ __forceinline__ void xcd_barrier_complete(unsigned* bar, unsigned x, unsigned& nloc, unsigned& nx) {
    const unsigned G = gridDim.x * gridDim.y * gridDim.z;
    unsigned sum, cnt, mine, sp = 0u;
    for (;;) {
        sum = 0u; cnt = 0u; mine = 0u;
#pragma unroll
        for (unsigned j = 0; j < 16; ++j) { const unsigned c = xb_ld(&bar[XB_XCNT(j)]); sum += c; cnt += (c > 0u) ? 1u : 0u; mine = (j == x) ? c : mine; }
        if (sum == G) break;
        __builtin_amdgcn_s_sleep(1);
        if ((++sp & 255u) == 0u) { if (xb_ld(&bar[XB_TMO])) break; if (sp > XB_SPIN_CAP) { atomicAdd(&bar[XB_TMO], 1u); break; } }
    }
    nloc = mine > 0u ? mine : 1u; nx = cnt > 0u ? cnt : 1u;
}

__device__ __forceinline__ void xcd_barrier(const XcdBarrier& b) {
    asm volatile("s_waitcnt vmcnt(0)" ::: "memory");
    __syncthreads();
    if (threadIdx.x == 0) {
        unsigned* bar = b.bar;
        __builtin_amdgcn_s_waitcnt(0);
        unsigned nloc = b.st[0], nx = b.st[1];
        if (nloc == 0u) { xcd_barrier_complete(bar, b.x, nloc, nx); b.st[0] = nloc; b.st[1] = nx; }
        const unsigned old = xb_add(&bar[XB_XSUB(b.x)], 1u);
        const unsigned gen = old / nloc;
        if (old + 1u == (gen + 1u) * nloc) {
            __builtin_amdgcn_fence(__ATOMIC_RELEASE, "agent");
            asm volatile("s_waitcnt vmcnt(0)" ::: "memory");
            const unsigned og = xb_add(&bar[XB_TOP], 1u);
            const unsigned tg = og / nx;
            if (og + 1u == (tg + 1u) * nx) xb_add(&bar[XB_TOPGEN], 1u);
            else XB_SPIN(xb_ld(&bar[XB_TOPGEN]) == tg, bar);
            __builtin_amdgcn_fence(__ATOMIC_ACQUIRE, "agent");
            xb_add(&bar[XB_XGEN(b.x)], 1u);
            asm volatile("s_waitcnt vmcnt(0)" ::: "memory");
        } else {
            XB_SPIN(xb_ld(&bar[XB_XGEN(b.x)]) == gen, bar);
            __builtin_amdgcn_fence(__ATOMIC_ACQUIRE, "agent");
            asm volatile("s_waitcnt vmcnt(0)" ::: "memory");
        }
    }
    __syncthreads();
}
constexpr int NWAVES = 8;
constexpr int M = 16384, D = 1024, FF = 2816, SEQ = 4096, NB = 4;
constexpr int MEMROWS = 1024;
constexpr float LN_EPS = 1e-5f;
constexpr float ALPHA = 1.189207115002721f;
constexpr size_t MiB = 1u << 20;
constexpr size_t WS_CTL = 0, CTL_ZERO_BYTES = 1 * MiB;
constexpr size_t WS_W1GU = 1 * MiB;
constexpr size_t WS_W1D = 12 * MiB;
constexpr size_t WS_WIN = 18 * MiB;
constexpr size_t WS_WOUT = 24 * MiB;
constexpr size_t WS_WQ = 26 * MiB, WS_WK = 28 * MiB, WS_WV = 30 * MiB, WS_WO = 32 * MiB;
constexpr size_t WS_W2GU = 34 * MiB, WS_W2D = 45 * MiB;
constexpr size_t WS_KB = 51 * MiB, WS_VTB = 53 * MiB, WS_MEMLN = 55 * MiB;
constexpr size_t WS_XN = 57 * MiB;
constexpr size_t WS_HB = 89 * MiB;
constexpr size_t WS_PQ = 89 * MiB, WS_PFZ = 105 * MiB, WS_PG = 137 * MiB, WS_PU = 153 * MiB, WS_IVT = 169 * MiB, WS_VT = 185 * MiB, WS_MIX = 201 * MiB;
constexpr size_t WS_QB = 89 * MiB, WS_PB = 121 * MiB, WS_OB = 153 * MiB;
constexpr size_t WS_END = 256 * MiB;
constexpr int CW_BAR = 4096;
constexpr int RING_OFF = 0, RING_BYTES = 131072;
constexpr int LDSCTL_OFF = RING_BYTES, MISC_OFF = LDSCTL_OFF + 320;
constexpr int LDS_BYTES = 147456;

typedef pg8::bf16_t bf16;
__device__ __forceinline__ float bf2f(bf16 v) { return __uint_as_float((unsigned)v << 16); }
__device__ __forceinline__ unsigned pk2(float lo, float hi) { return pg8::cvt_pk_bf16(lo, hi); }
__device__ __forceinline__ float wave_sum(float v) {
#pragma unroll
    for (int o = 1; o < 64; o <<= 1) v += __shfl_xor(v, o);
    return v;
}
__device__ __forceinline__ void transpose_item(const float* W, int K, int N, int k0, int n0, bf16* dstrow, LAS float* scr, int lane) {
#pragma unroll 8
    for (int i = 0; i < 32; ++i) { const int kk = 2 * i + (lane >> 5); scr[kk * 33 + (lane & 31)] = W[(size_t)(k0 + kk) * N + n0 + (lane & 31)]; }
    LDS_WAIT(); asm volatile("" ::: "memory");
    const int c = lane & 7;
#pragma unroll
    for (int j = 0; j < 4; ++j) { const int n = (lane >> 3) + 8 * j; const LAS float* s = scr + (8 * c) * 33 + n;
        v4u o; o.x = pk2(s[0 * 33], s[1 * 33]); o.y = pk2(s[2 * 33], s[3 * 33]); o.z = pk2(s[4 * 33], s[5 * 33]); o.w = pk2(s[6 * 33], s[7 * 33]);
        *(v4u*)(dstrow + (size_t)n * K + k0 + 8 * c) = o; }
    LDS_WAIT(); asm volatile("" ::: "memory");
}
__device__ __forceinline__ void transpose_matrix_item(const float* W, int K, int N, bf16* WT, int kind, int item, LAS float* scr, int lane) {
    const int nblk = N / 32, kb = item / nblk, nb = item % nblk, k0 = 64 * kb, n0 = 32 * nb;
    int r0 = n0;
    if (kind == 1) r0 = (n0 >> 7) * 256 + (n0 & 127);
    else if (kind == 2) r0 = (n0 >> 7) * 256 + 128 + (n0 & 127);
    else if (kind == 3) { const int seg = n0 >> 9, w = n0 & 511; const int base = seg == 0 ? 0 : seg == 1 ? 512 : seg == 2 ? 2048 : seg == 3 ? 1024 : seg == 4 ? 1536 : 2560; r0 = base + w; }
    transpose_item(W, K, N, k0, n0, WT + (size_t)r0 * K, scr, lane);
}
__device__ __forceinline__ void ln_row(const float* src, float* dstf, bf16* dstb, const float* g, const float* b, int lane) {
    const f32x4* xr = (const f32x4*)src + lane;
    f32x4 v[4]; float s = 0.f;
#pragma unroll
    for (int j = 0; j < 4; ++j) { v[j] = xr[64 * j]; s += (v[j].x + v[j].y) + (v[j].z + v[j].w); }
    const float mean = wave_sum(s) * (1.f / 1024.f); float s2 = 0.f;
#pragma unroll
    for (int j = 0; j < 4; ++j) { v[j] = v[j] - mean; s2 += (v[j].x * v[j].x + v[j].y * v[j].y) + (v[j].z * v[j].z + v[j].w * v[j].w); }
    const float rstd = 1.f / sqrtf(wave_sum(s2) * (1.f / 1024.f) + LN_EPS);
#pragma unroll
    for (int j = 0; j < 4; ++j) { const f32x4 gg = ((const f32x4*)g)[lane + 64 * j], bb = ((const f32x4*)b)[lane + 64 * j];
        const f32x4 o = v[j] * rstd * gg + bb;
        if (dstf) ((f32x4*)dstf)[lane + 64 * j] = o;
        if (dstb) { unsigned long long w = (unsigned long long)pk2(o.x, o.y) | ((unsigned long long)pk2(o.z, o.w) << 32); ((unsigned long long*)dstb)[lane + 64 * j] = w; } }
}


__device__ __forceinline__ void hgrn2_naive(LAS unsigned char* lds, int unit, const bf16* PQ, const float* PFZ, const bf16* IVT, const float* lbl, float* ORAW, int tid, int lane, int wave) {
    const int dvg = unit & 7, h = (unit >> 3) & 3, b = unit >> 5;
    LAS float* qs = (LAS float*)lds; LAS float* fs = qs + 32 * 128; LAS float* ks = fs + 32 * 128; LAS float* vs = ks + 32 * 128; LAS float* os = vs + 32 * 16;
    const int dk = tid & 127, tq = tid >> 7;
    const float l0 = lbl[h * 128 + dk], l1 = lbl[512 + h * 128 + dk];
    const float lb = 1.0f / (1.0f + __expf(l1 - l0));
    const int dkp = lane & 31, dvl = 2 * wave + (lane >> 5);
    float S0 = 0.f, S1 = 0.f, S2 = 0.f, S3 = 0.f;
    const size_t tokb = (size_t)b * SEQ;
    const int vj = tid >> 5, vt = tid & 31;
    bf16 qreg[8]; float zreg[8]; bf16 vreg;
#pragma unroll
    for (int i = 0; i < 8; ++i) { const size_t tok = tokb + (tq + 4 * i); qreg[i] = PQ[tok * 512 + h * 128 + dk]; zreg[i] = PFZ[tok * 512 + h * 128 + dk]; }
    vreg = IVT[(size_t)(h * 128 + dvg * 16 + vj) * M + tokb + vt];
    for (int ch = 0; ch < SEQ / 32; ++ch) {
        const size_t tok0 = tokb + (size_t)ch * 32;
#pragma unroll
        for (int i = 0; i < 8; ++i) { const int t = tq + 4 * i; const float kk = (1.0f - lb) / (1.0f + __expf(zreg[i]));
            qs[t * 128 + dk] = bf2f(qreg[i]); ks[t * 128 + dk] = kk; fs[t * 128 + dk] = 1.0f - kk; }
        vs[vt * 16 + vj] = bf2f(vreg);
        __syncthreads();
        if (ch + 1 < SEQ / 32) {
#pragma unroll
            for (int i = 0; i < 8; ++i) { const size_t tok = tok0 + 32 + (tq + 4 * i); qreg[i] = PQ[tok * 512 + h * 128 + dk]; zreg[i] = PFZ[tok * 512 + h * 128 + dk]; }
            vreg = IVT[(size_t)(h * 128 + dvg * 16 + vj) * M + tok0 + 32 + vt];
        }
        for (int t = 0; t < 32; ++t) {
            const f32x4 q4 = *(const LAS f32x4*)(qs + t * 128 + 4 * dkp), f4 = *(const LAS f32x4*)(fs + t * 128 + 4 * dkp), k4 = *(const LAS f32x4*)(ks + t * 128 + 4 * dkp);
            const float v = vs[t * 16 + dvl];
            S0 = f4.x * S0 + k4.x * v; S1 = f4.y * S1 + k4.y * v; S2 = f4.z * S2 + k4.z * v; S3 = f4.w * S3 + k4.w * v;
            float p = (q4.x * S0 + q4.y * S1) + (q4.z * S2 + q4.w * S3);
            p += __shfl_xor(p, 16); p += __shfl_xor(p, 8); p += __shfl_xor(p, 4); p += __shfl_xor(p, 2); p += __shfl_xor(p, 1);
            if (dkp == 0) os[t * 16 + dvl] = p;
        }
        __syncthreads();
        { const int t = tid >> 4, j = tid & 15; ORAW[(tok0 + t) * 512 + h * 128 + dvg * 16 + j] = os[t * 16 + j]; }
        __syncthreads();
    }
}
__device__ __forceinline__ void sgu_naive(LAS unsigned char* lds, int unit, const bf16* VT, const bf16* PU, const float* lng, const float* lnb, const float* Ws, const float* bs, bf16* MIX, int tid) {
    const int g = unit & 3, n = (unit >> 2) & 31, b = unit >> 7;
    const size_t tok0 = (size_t)b * SEQ + (size_t)n * 128;
    LAS float* vn = (LAS float*)lds;
    LAS float* mu = vn + 128 * 129; LAS float* rs = mu + 128;
#pragma unroll 4
    for (int i = 0; i < 32; ++i) { const int idx = tid + 512 * i, s = idx & 127, c = idx >> 7; vn[s * 129 + c] = bf2f(VT[(size_t)(g * 128 + c) * M + tok0 + s]); }
    __syncthreads();
    if (tid < 128) { const int s = tid; float sum = 0.f;
        for (int c = 0; c < 128; ++c) sum += vn[s * 129 + c];
        const float mean = sum * (1.f / 128.f); float sq = 0.f;
        for (int c = 0; c < 128; ++c) { const float d = vn[s * 129 + c] - mean; sq += d * d; }
        mu[s] = mean; rs[s] = 1.f / sqrtf(sq * (1.f / 128.f) + LN_EPS); }
    __syncthreads();
    { const int c = tid & 127; const float gg = lng[g * 128 + c], bb = lnb[g * 128 + c];
#pragma unroll 4
      for (int i = 0; i < 32; ++i) { const int s = (tid >> 7) + 4 * i; vn[s * 129 + c] = (vn[s * 129 + c] - mu[s]) * rs[s] * gg + bb; } }
    __syncthreads();
    { const int c = tid & 127; const int tq = __builtin_amdgcn_readfirstlane(tid >> 7);
      for (int i = 0; i < 32; ++i) { const int t = 4 * i + tq; const float* wrow = Ws + (size_t)(g * 128 + t) * 128; float acc = 0.f;
          for (int s = 0; s <= t; ++s) acc += wrow[s] * vn[s * 129 + c];
          const float so = acc + bs[g * 128 + t];
          const float uu = bf2f(PU[(tok0 + t) * 512 + g * 128 + c]);
          const unsigned w = pk2(uu * so, 0.f);
          MIX[(tok0 + t) * D + 512 + g * 128 + c] = (bf16)(w & 0xffffu); } }
    __syncthreads();
}
struct Args { const float* in[30]; float* out; unsigned char* ws; int ph_lo, ph_hi, li, pad; };
constexpr int N_PHASES = 17;

__global__ void __launch_bounds__(NWAVES * 64, 2) mk_fwd(Args args) {
    extern __shared__ __attribute__((aligned(16))) unsigned char lds_raw[];
    LAS unsigned char* lds = (LAS unsigned char*)lds_raw;
    volatile LAS unsigned* MISC = (volatile LAS unsigned*)(lds + MISC_OFF);
    const int tid = threadIdx.x, lane = tid & 63, wave = __builtin_amdgcn_readfirstlane(tid >> 6);
    const int G = gridDim.x, bx = blockIdx.x;
    const int vcu = (G % 8 == 0) ? (bx % 8) * (G / 8) + bx / 8 : bx;
    unsigned char* ws = args.ws;
    unsigned* ctl = (unsigned*)(ws + WS_CTL);
    for (int u = tid; u < (LDS_BYTES - LDSCTL_OFF) / 4; u += NWAVES * 64) ((LAS unsigned*)(lds + LDSCTL_OFF))[u] = 0u;
    __syncthreads();
    XcdBarrier bar; bar.bar = ctl + CW_BAR + args.li * XCD_BAR_WORDS; bar.x = 0; bar.st = nullptr;
    const int lo = args.ph_lo, hi = args.ph_hi;
    if (hi - lo > 1) bar = xcd_barrier_post(ctl + CW_BAR + args.li * XCD_BAR_WORDS, MISC + 8);
#define IN(k) (lo <= (k) && (k) < hi)
#define SEAM(k) do { if (IN(k) && IN((k) + 1)) xcd_barrier(bar); } while (0)
    const float* x = args.in[0];
    float* out = args.out;
    bf16* W1GU = (bf16*)(ws + WS_W1GU); bf16* W1D = (bf16*)(ws + WS_W1D); bf16* WIN = (bf16*)(ws + WS_WIN); bf16* WOUT = (bf16*)(ws + WS_WOUT);
    bf16* WQ = (bf16*)(ws + WS_WQ); bf16* WK = (bf16*)(ws + WS_WK); bf16* WV = (bf16*)(ws + WS_WV); bf16* WO = (bf16*)(ws + WS_WO);
    bf16* W2GU = (bf16*)(ws + WS_W2GU); bf16* W2D = (bf16*)(ws + WS_W2D);
    bf16* KB = (bf16*)(ws + WS_KB); bf16* VTB = (bf16*)(ws + WS_VTB); bf16* MEMLN = (bf16*)(ws + WS_MEMLN);
    bf16* XN = (bf16*)(ws + WS_XN); float* ORAW = (float*)(ws + WS_XN); bf16* HB = (bf16*)(ws + WS_HB);
    bf16* PQ = (bf16*)(ws + WS_PQ); float* PFZ = (float*)(ws + WS_PFZ); bf16* PG = (bf16*)(ws + WS_PG); bf16* PU = (bf16*)(ws + WS_PU);
    bf16* IVT = (bf16*)(ws + WS_IVT); bf16* VT = (bf16*)(ws + WS_VT); bf16* MIX = (bf16*)(ws + WS_MIX);
    bf16* QB = (bf16*)(ws + WS_QB); bf16* PB = (bf16*)(ws + WS_PB); bf16* OB = (bf16*)(ws + WS_OB);
    const int gw = vcu * NWAVES + wave, NGW = G * NWAVES;

    if (IN(0)) {
        LAS float* scr = (LAS float*)(lds + RING_OFF + wave * 16384);
        constexpr int I_GU = (D / 64) * (FF / 32), I_DN = (FF / 64) * (D / 32), I_IN = (D / 64) * (3072 / 32), I_SQ = (D / 64) * (D / 32);
        constexpr int NITEMS = 4 * I_GU + 2 * I_DN + I_IN + 5 * I_SQ;
        for (int it = gw; it < NITEMS; it += NGW) {
            int r = it;
            if (r < I_GU) { transpose_matrix_item(args.in[2], D, FF, W1GU, 1, r, scr, lane); continue; } r -= I_GU;
            if (r < I_GU) { transpose_matrix_item(args.in[3], D, FF, W1GU, 2, r, scr, lane); continue; } r -= I_GU;
            if (r < I_DN) { transpose_matrix_item(args.in[4], FF, D, W1D, 0, r, scr, lane); continue; } r -= I_DN;
            if (r < I_IN) { transpose_matrix_item(args.in[7], D, 3072, WIN, 3, r, scr, lane); continue; } r -= I_IN;
            if (r < I_SQ) { transpose_matrix_item(args.in[14], D, D, WOUT, 0, r, scr, lane); continue; } r -= I_SQ;
            if (r < I_SQ) { transpose_matrix_item(args.in[19], D, D, WQ, 0, r, scr, lane); continue; } r -= I_SQ;
            if (r < I_SQ) { transpose_matrix_item(args.in[20], D, D, WK, 0, r, scr, lane); continue; } r -= I_SQ;
            if (r < I_SQ) { transpose_matrix_item(args.in[21], D, D, WV, 0, r, scr, lane); continue; } r -= I_SQ;
            if (r < I_SQ) { transpose_matrix_item(args.in[22], D, D, WO, 0, r, scr, lane); continue; } r -= I_SQ;
            if (r < I_GU) { transpose_matrix_item(args.in[25], D, FF, W2GU, 1, r, scr, lane); continue; } r -= I_GU;
            if (r < I_GU) { transpose_matrix_item(args.in[26], D, FF, W2GU, 2, r, scr, lane); continue; } r -= I_GU;
            transpose_matrix_item(args.in[27], FF, D, W2D, 0, r, scr, lane);
        }
        for (size_t i = (size_t)(vcu * 512 + tid); i < (size_t)M * D / 8; i += (size_t)G * 512) {
            const f32x4 a = ((const f32x4*)x)[2 * i], b = ((const f32x4*)x)[2 * i + 1];
            v4u o; o.x = pk2(a.x, a.y); o.y = pk2(a.z, a.w); o.z = pk2(b.x, b.y); o.w = pk2(b.z, b.w);
            ((v4u*)XN)[i] = o; }
        for (int m = gw; m < MEMROWS; m += NGW) ln_row(args.in[1] + (size_t)m * D, nullptr, MEMLN + (size_t)m * D, args.in[17], args.in[18], lane);
    }
    SEAM(0);
    if (IN(1)) {
        { pg8::Gemm g{XN, W1GU, D, D, D}; pg8::GridOrder S; S.init(M, 2 * FF, D, D, G, bx); pg8::EpiSwiglu E{HB, FF};
          pg8::gemm_phase<pg8::EpiSwiglu, pg8::GridOrder, true>(lds + RING_OFF, g, S, E); }
        { pg8::Gemm g{MEMLN, WK, D, D, D}; pg8::SmallOrder S; S.init(MEMROWS, D, D, D, bx - 128); pg8::EpiBf16<0> E{KB, D, 1.0f};
          pg8::gemm_phase<pg8::EpiBf16<0>, pg8::SmallOrder, true>(lds + RING_OFF, g, S, E); }
        { pg8::Gemm g{WV, MEMLN, D, D, D}; pg8::SmallOrder S; S.init(D, MEMROWS, D, D, bx - 144); pg8::EpiBf16<0> E{VTB, MEMROWS, 1.0f};
          pg8::gemm_phase<pg8::EpiBf16<0>, pg8::SmallOrder, true>(lds + RING_OFF, g, S, E); }
    }
    SEAM(1);
    if (IN(2)) {
        pg8::Gemm g{HB, W1D, FF, FF, FF}; pg8::GridOrder S; S.init(M, D, FF, FF, G, bx); pg8::EpiResid E{x, out, ALPHA, 0.5f};
        pg8::gemm_phase<pg8::EpiResid, pg8::GridOrder, true>(lds + RING_OFF, g, S, E);
    }
    SEAM(2);
    if (IN(3)) { for (int m = gw; m < M; m += NGW) ln_row(out + (size_t)m * D, out + (size_t)m * D, XN + (size_t)m * D, args.in[5], args.in[6], lane); }
    SEAM(3);
    if (IN(4)) {
        { pg8::Gemm g{XN, WIN, D, D, D}; pg8::GridOrder S; S.init(M, 2048, D, D, G, bx); typedef pg8::EpiProj<(long)((WS_PG - WS_PQ) / 2), (long)((WS_PU - WS_PQ) / 2)> EP; EP E{PQ, PFZ};
          pg8::gemm_phase<EP, pg8::GridOrder, true>(lds + RING_OFF, g, S, E); }
        { pg8::Gemm g{WIN + (size_t)2048 * D, XN, D, D, D}; pg8::GridOrder S; S.init(1024, M, D, D, G, bx); typedef pg8::EpiProjT<(long)((WS_VT - WS_IVT) / 2)> EPT; EPT E{IVT, M};
          pg8::gemm_phase<EPT, pg8::GridOrder, true>(lds + RING_OFF, g, S, E); }
    }
    SEAM(4);
    if (IN(5)) {
        if (bx < 128) hgrn2_naive(lds, bx, PQ, PFZ, IVT, args.in[8], ORAW, tid, lane, wave);
        else { for (int u = bx - 128; u < 512; u += 128) sgu_naive(lds, u, VT, PU, args.in[10], args.in[11], args.in[12], args.in[13], MIX, tid); }
    }
    SEAM(5);
    if (IN(6)) {
        const float* ng = args.in[9];
        for (int m = gw; m < M; m += NGW) {
            const f32x4 a = ((const f32x4*)(ORAW + (size_t)m * 512))[2 * lane], b = ((const f32x4*)(ORAW + (size_t)m * 512))[2 * lane + 1];
            float ss = (a.x * a.x + a.y * a.y) + (a.z * a.z + a.w * a.w) + (b.x * b.x + b.y * b.y) + (b.z * b.z + b.w * b.w);
            ss += __shfl_xor(ss, 1); ss += __shfl_xor(ss, 2); ss += __shfl_xor(ss, 4); ss += __shfl_xor(ss, 8);
            const float rs = 1.f / sqrtf(ss * (1.f / 128.f) + LN_EPS);
            const int dv0 = (lane & 15) * 8;
            const f32x4 g0 = *(const f32x4*)(ng + dv0), g1 = *(const f32x4*)(ng + dv0 + 4);
            const v4u gq = ((const v4u*)(PG + (size_t)m * 512))[lane];
            float gv[8]; gv[0] = __uint_as_float(gq.x << 16); gv[1] = __uint_as_float(gq.x & 0xffff0000u); gv[2] = __uint_as_float(gq.y << 16); gv[3] = __uint_as_float(gq.y & 0xffff0000u);
            gv[4] = __uint_as_float(gq.z << 16); gv[5] = __uint_as_float(gq.z & 0xffff0000u); gv[6] = __uint_as_float(gq.w << 16); gv[7] = __uint_as_float(gq.w & 0xffff0000u);
            v4u o; o.x = pk2(a.x * rs * g0.x * gv[0], a.y * rs * g0.y * gv[1]); o.y = pk2(a.z * rs * g0.z * gv[2], a.w * rs * g0.w * gv[3]);
            o.z = pk2(b.x * rs * g1.x * gv[4], b.y * rs * g1.y * gv[5]); o.w = pk2(b.z * rs * g1.z * gv[6], b.w * rs * g1.w * gv[7]);
            *(v4u*)(MIX + (size_t)m * D + lane * 8) = o;
        }
    }
    SEAM(6);
    if (IN(7)) {
        pg8::Gemm g{MIX, WOUT, D, D, D}; pg8::GridOrder S; S.init(M, D, D, D, G, bx); pg8::EpiResid E{out, out, ALPHA, 1.0f};
        pg8::gemm_phase<pg8::EpiResid, pg8::GridOrder, true>(lds + RING_OFF, g, S, E);
    }
    SEAM(7);
    if (IN(8)) { for (int m = gw; m < M; m += NGW) ln_row(out + (size_t)m * D, out + (size_t)m * D, XN + (size_t)m * D, args.in[15], args.in[16], lane); }
    SEAM(8);
    if (IN(9)) {
        pg8::Gemm g{XN, WQ, D, D, D}; pg8::GridOrder S; S.init(M, D, D, D, G, bx); pg8::EpiBf16<0> E{QB, D, 0.0625f};
        pg8::gemm_phase<pg8::EpiBf16<0>, pg8::GridOrder, true>(lds + RING_OFF, g, S, E);
    }
    SEAM(9);
    if (IN(10)) {
        pg8::Gemm g{QB, KB, D, D, 256}; pg8::AttnOrder S{bx, 0}; pg8::EpiSoftmax E{PB, D};
        pg8::gemm_phase<pg8::EpiSoftmax, pg8::AttnOrder, false>(lds + RING_OFF, g, S, E);
    }
    SEAM(10);
    if (IN(11)) {
        pg8::Gemm g{PB, VTB, D, MEMROWS, 256}; pg8::AttnOrder S{bx, 1}; pg8::EpiBf16<0> E{OB, D, 1.0f};
        pg8::gemm_phase<pg8::EpiBf16<0>, pg8::AttnOrder, true>(lds + RING_OFF, g, S, E);
    }
    SEAM(11);
    if (IN(12)) {
        pg8::Gemm g{OB, WO, D, D, D}; pg8::GridOrder S; S.init(M, D, D, D, G, bx); pg8::EpiResid E{out, out, ALPHA, 1.0f};
        pg8::gemm_phase<pg8::EpiResid, pg8::GridOrder, true>(lds + RING_OFF, g, S, E);
    }
    SEAM(12);
    if (IN(13)) { for (int m = gw; m < M; m += NGW) ln_row(out + (size_t)m * D, out + (size_t)m * D, XN + (size_t)m * D, args.in[23], args.in[24], lane); }
    SEAM(13);
    if (IN(14)) {
        pg8::Gemm g{XN, W2GU, D, D, D}; pg8::GridOrder S; S.init(M, 2 * FF, D, D, G, bx); pg8::EpiSwiglu E{HB, FF};
        pg8::gemm_phase<pg8::EpiSwiglu, pg8::GridOrder, true>(lds + RING_OFF, g, S, E);
    }
    SEAM(14);
    if (IN(15)) {
        pg8::Gemm g{HB, W2D, FF, FF, FF}; pg8::GridOrder S; S.init(M, D, FF, FF, G, bx); pg8::EpiResid E{out, out, ALPHA, 0.5f};
        pg8::gemm_phase<pg8::EpiResid, pg8::GridOrder, true>(lds + RING_OFF, g, S, E);
    }
    SEAM(15);
    if (IN(16)) { for (int m = gw; m < M; m += NGW) ln_row(out + (size_t)m * D, out + (size_t)m * D, nullptr, args.in[28], args.in[29], lane); }
#undef IN
#undef SEAM
}

#ifndef MK_N_LAUNCHES
#define MK_N_LAUNCHES 1
#endif
extern "C" void kernel_launch(void* const* d_in, const int* in_sizes, int n_in, void* d_out, int out_size, void* d_ws, size_t ws_size, hipStream_t stream) {
    static int grid = 0;
    if (grid == 0) {
        if (n_in != 30 || out_size != M * D || ws_size < WS_END) { fprintf(stderr, "kernel_launch: unexpected shapes (n_in %d, out %d, ws %zu)\n", n_in, out_size, ws_size); grid = -1; return; }
        int dev = 0, cus = 0;
        if (hipGetDevice(&dev) != hipSuccess || hipDeviceGetAttribute(&cus, hipDeviceAttributeMultiprocessorCount, dev) != hipSuccess) { grid = -1; return; }
        if (hipFuncSetAttribute((const void*)mk_fwd, hipFuncAttributeMaxDynamicSharedMemorySize, LDS_BYTES) != hipSuccess) { fprintf(stderr, "kernel_launch: hipFuncSetAttribute failed\n"); grid = -1; return; }
        int per_cu = 0;
        (void)hipOccupancyMaxActiveBlocksPerMultiprocessor(&per_cu, (const void*)mk_fwd, NWAVES * 64, LDS_BYTES);
        (void)hipGetLastError();
        grid = cus;
        if (grid != 256) fprintf(stderr, "kernel_launch: %d CUs (built for 256)\n", grid);
    }
    if (grid < 0) return;
    (void)hipMemsetAsync((char*)d_ws + WS_CTL, 0, CTL_ZERO_BYTES, stream);
    Args a{};
    for (int i = 0; i < 30; ++i) a.in[i] = (const float*)d_in[i];
    a.out = (float*)d_out; a.ws = (unsigned char*)d_ws;
    if (MK_N_LAUNCHES == 1) {
        a.ph_lo = 0; a.ph_hi = N_PHASES; a.li = 0;
        hipLaunchKernelGGL(mk_fwd, dim3(grid), dim3(NWAVES * 64), LDS_BYTES, stream, a);
    } else {
        for (int p = 0; p < N_PHASES; ++p) { a.ph_lo = p; a.ph_hi = p + 1; a.li = 0; hipLaunchKernelGGL(mk_fwd, dim3(grid), dim3(NWAVES * 64), LDS_BYTES, stream, a); }
    }
}
```

```cpp
#include <hip/hip_runtime.h>
#include <cstdio>
#include <cstdint>
namespace pg8 {
#define PG8_LAS __attribute__((address_space(3)))
typedef unsigned short bf16_t;
typedef short bf16x8 __attribute__((ext_vector_type(8)));
typedef float f32x4 __attribute__((ext_vector_type(4)));
typedef float f32x2 __attribute__((ext_vector_type(2)));
typedef unsigned u32x4 __attribute__((ext_vector_type(4)));
typedef unsigned u32x2 __attribute__((ext_vector_type(2)));
constexpr int BM = 256, BK = 64, HALF = 128, HTB = HALF * BK * 2, STAGE_BYTES = 8 * HTB, NXCD = 8, WGM = 8;

__host__ __device__ __forceinline__ int lds_byte(int r, int c) { const int st = (r >> 4) * 2 + (c >> 5), rr = r & 15, cc = c & 31, ob = rr * 64 + cc * 2; return st * 1024 + (ob ^ (((ob >> 9) & 1) << 5)); }
__host__ __device__ __forceinline__ void stage_rc(int b, int& R, int& C) { const int st = b / 1024, sb = b % 1024, swz = sb ^ (((sb >> 9) & 1) << 5); R = (st >> 1) * 16 + swz / 64; C = (st & 1) * 32 + (swz % 64) / 2; }
__host__ __device__ __forceinline__ int perm32(int rho) { const int n = rho >> 4, i = rho & 15; return 8 * (i >> 2) + 4 * n + (i & 3); }

struct Unit { int pm, pn; unsigned aoff, boff; };
struct Gemm { const bf16_t* A; const bf16_t* Bt; int lda, ldb, K; };

struct GridOrder {
    int nM, nN, nwg, G, c; unsigned astep, bstep;
    __device__ void init(int M, int N, int lda, int ldb, int G_, int c_) { nM = M / BM; nN = N / BM; nwg = nM * nN; G = G_; c = c_; astep = (unsigned)(BM * lda * 2); bstep = (unsigned)(BM * ldb * 2); }
    __device__ bool next(int i, Unit& u) const {
        const long L = (long)i * G + c; if (L >= nwg) return false;
        int wgid = (int)L; { const int q = nwg / NXCD, r = nwg % NXCD, xcd = wgid % NXCD, off = wgid / NXCD; wgid = (xcd < r ? xcd * (q + 1) : r * (q + 1) + (xcd - r) * q) + off; }
        const int nig = WGM * nN, gid = wgid / nig, fm = gid * WGM, gsz = (nM - fm) < WGM ? (nM - fm) : WGM;
        u.pm = fm + ((wgid % nig) % gsz); u.pn = (wgid % nig) / gsz; u.aoff = (unsigned)u.pm * astep; u.boff = (unsigned)u.pn * bstep; return true;
    }
};
struct SmallOrder {
    int nM, nN, c; unsigned astep, bstep;
    __device__ void init(int M, int N, int lda, int ldb, int c_rel) { nM = M / BM; nN = N / BM; c = c_rel; astep = (unsigned)(BM * lda * 2); bstep = (unsigned)(BM * ldb * 2); }
    __device__ bool next(int i, Unit& u) const {
        if (i > 0 || c < 0 || c >= nM * nN) return false;
        u.pm = c / nN; u.pn = c % nN; u.aoff = (unsigned)u.pm * astep; u.boff = (unsigned)u.pn * bstep; return true;
    }
};
struct AttnOrder {
    int c, mode;
    __device__ bool next(int i, Unit& u) const {
        if (i > 0 || c >= 256) return false;
        const int x = c & 7, j = c >> 3, bh = 2 * x + (j >> 4), qb = j & 15, b = bh >> 2, h = bh & 3;
        u.pm = b * 16 + qb; u.pn = h;
        u.aoff = (unsigned)(((size_t)u.pm * 256 * 1024 + h * 256) * 2);
        u.boff = mode == 0 ? (unsigned)(((size_t)b * 256 * 1024 + h * 256) * 2) : (unsigned)(((size_t)h * 256 * 1024 + b * 256) * 2);
        return true;
    }
};

typedef __bf16 bf16x2_t __attribute__((ext_vector_type(2)));
__device__ __forceinline__ unsigned cvt_pk_bf16(float lo, float hi) { f32x2 v = {lo, hi}; bf16x2_t b = __builtin_convertvector(v, bf16x2_t); return __builtin_bit_cast(unsigned, b); }
__device__ __forceinline__ float fast_rcp(float x) { return __builtin_amdgcn_rcpf(x); }
__device__ __forceinline__ float silu_f(float x) { return x * fast_rcp(1.0f + __expf(-x)); }
__device__ __forceinline__ float gelu_tanh_f(float x) { const float u = 1.5957691216f * (x + 0.044715f * x * x * x); return x * fast_rcp(1.0f + __expf(-u)); }

template <int ACT  > struct EpiBf16 {
    static constexpr bool PERM = true, AFTER_DRAIN = false;
    bf16_t* O; int ldc; float scale;
    __device__ __forceinline__ void operator()(const f32x4 (&acc)[2][2][4][2], const Unit& u, int wr, int wc, int fr, int fq) const {
        const int row0 = u.pm * BM + wr * 64 + fr, col0 = u.pn * BM + wc * 32 + 8 * fq;
#pragma unroll
        for (int ai = 0; ai < 2; ++ai)
#pragma unroll
            for (int m = 0; m < 4; ++m) { bf16_t* rowp = O + (size_t)(row0 + ai * HALF + m * 16) * ldc + col0;
#pragma unroll
                for (int bj = 0; bj < 2; ++bj) { f32x4 v0 = acc[ai][bj][m][0], v1 = acc[ai][bj][m][1];
                    if (ACT == 1) { for (int j = 0; j < 4; ++j) { v0[j] = silu_f(v0[j]); v1[j] = silu_f(v1[j]); } }
                    if (ACT == 2) { for (int j = 0; j < 4; ++j) { v0[j] = gelu_tanh_f(v0[j]); v1[j] = gelu_tanh_f(v1[j]); } }
                    v0 = v0 * scale; v1 = v1 * scale; u32x4 w; w.x = cvt_pk_bf16(v0[0], v0[1]); w.y = cvt_pk_bf16(v0[2], v0[3]); w.z = cvt_pk_bf16(v1[0], v1[1]); w.w = cvt_pk_bf16(v1[2], v1[3]);
                    *(u32x4*)(rowp + bj * HALF) = w; } }
    }
};
struct EpiSwiglu {
    static constexpr bool PERM = true, AFTER_DRAIN = false;
    bf16_t* O; int ldc;
    __device__ __forceinline__ void operator()(const f32x4 (&acc)[2][2][4][2], const Unit& u, int wr, int wc, int fr, int fq) const {
        const int row0 = u.pm * BM + wr * 64 + fr, col0 = u.pn * HALF + wc * 32 + 8 * fq;
#pragma unroll
        for (int ai = 0; ai < 2; ++ai)
#pragma unroll
            for (int m = 0; m < 4; ++m) { bf16_t* rowp = O + (size_t)(row0 + ai * HALF + m * 16) * ldc + col0;
                f32x4 g0 = acc[ai][0][m][0], g1 = acc[ai][0][m][1]; const f32x4 u0 = acc[ai][1][m][0], u1 = acc[ai][1][m][1];
#pragma unroll
                for (int j = 0; j < 4; ++j) { g0[j] = silu_f(g0[j]) * u0[j]; g1[j] = silu_f(g1[j]) * u1[j]; }
                u32x4 w; w.x = cvt_pk_bf16(g0[0], g0[1]); w.y = cvt_pk_bf16(g0[2], g0[3]); w.z = cvt_pk_bf16(g1[0], g1[1]); w.w = cvt_pk_bf16(g1[2], g1[3]);
                *(u32x4*)rowp = w; }
    }
};
struct EpiResid {
    static constexpr bool PERM = true, AFTER_DRAIN = false;
    const float* base; float* out; float alpha, scale;
    __device__ __forceinline__ void operator()(const f32x4 (&acc)[2][2][4][2], const Unit& u, int wr, int wc, int fr, int fq) const {
        const int row0 = u.pm * BM + wr * 64 + fr, col0 = u.pn * BM + wc * 32 + 8 * fq;
#pragma unroll
        for (int ai = 0; ai < 2; ++ai)
#pragma unroll
            for (int m = 0; m < 4; ++m) { const size_t off = (size_t)(row0 + ai * HALF + m * 16) * 1024 + col0;
#pragma unroll
                for (int bj = 0; bj < 2; ++bj) {
                    const f32x4 b0 = *(const f32x4*)(base + off + bj * HALF), b1 = *(const f32x4*)(base + off + bj * HALF + 4);
                    *(f32x4*)(out + off + bj * HALF) = b0 * alpha + acc[ai][bj][m][0] * scale;
                    *(f32x4*)(out + off + bj * HALF + 4) = b1 * alpha + acc[ai][bj][m][1] * scale; } }
    }
};
template <long GOFF, long UOFF> struct EpiProj {
    static constexpr bool PERM = true, AFTER_DRAIN = false;
    bf16_t* Q; float* FZ;
    __device__ __forceinline__ void operator()(const f32x4 (&acc)[2][2][4][2], const Unit& u, int wr, int wc, int fr, int fq) const {
        const int seg = u.pn >> 1; const int row0 = u.pm * BM + wr * 64 + fr, col0 = (u.pn & 1) * BM + wc * 32 + 8 * fq;
        const long doff = seg == 2 ? GOFF : (seg == 3 ? UOFF : 0L);
        bf16_t* dst = Q + doff;
#pragma unroll
        for (int ai = 0; ai < 2; ++ai)
#pragma unroll
            for (int m = 0; m < 4; ++m) { const size_t off = (size_t)(row0 + ai * HALF + m * 16) * 512 + col0;
#pragma unroll
                for (int bj = 0; bj < 2; ++bj) { f32x4 v0 = acc[ai][bj][m][0], v1 = acc[ai][bj][m][1];
                    if (seg == 1) { *(f32x4*)(FZ + off + bj * HALF) = v0; *(f32x4*)(FZ + off + bj * HALF + 4) = v1; }
                    else {
                        if (seg == 2) { for (int j = 0; j < 4; ++j) { v0[j] = silu_f(v0[j]); v1[j] = silu_f(v1[j]); } }
                        if (seg == 3) { for (int j = 0; j < 4; ++j) { v0[j] = gelu_tanh_f(v0[j]); v1[j] = gelu_tanh_f(v1[j]); } }
                        u32x4 w; w.x = cvt_pk_bf16(v0[0], v0[1]); w.y = cvt_pk_bf16(v0[2], v0[3]); w.z = cvt_pk_bf16(v1[0], v1[1]); w.w = cvt_pk_bf16(v1[2], v1[3]);
                        *(u32x4*)(dst + off + bj * HALF) = w; } } }
    }
};
template <long VOFF> struct EpiProjT {
    static constexpr bool PERM = true, AFTER_DRAIN = false;
    bf16_t* IVT; int ldc;
    __device__ __forceinline__ void operator()(const f32x4 (&acc)[2][2][4][2], const Unit& u, int wr, int wc, int fr, int fq) const {
        const bool isv = u.pm >= 2; bf16_t* dst = IVT + (isv ? VOFF : 0L);
        const int row0 = (u.pm & 1) * BM + wr * 64 + fr, col0 = u.pn * BM + wc * 32 + 8 * fq;
#pragma unroll
        for (int ai = 0; ai < 2; ++ai)
#pragma unroll
            for (int m = 0; m < 4; ++m) { bf16_t* rowp = dst + (size_t)(row0 + ai * HALF + m * 16) * ldc + col0;
#pragma unroll
                for (int bj = 0; bj < 2; ++bj) { f32x4 v0 = acc[ai][bj][m][0], v1 = acc[ai][bj][m][1];
                    if (isv) { for (int j = 0; j < 4; ++j) { v0[j] = gelu_tanh_f(v0[j]); v1[j] = gelu_tanh_f(v1[j]); } }
                    u32x4 w; w.x = cvt_pk_bf16(v0[0], v0[1]); w.y = cvt_pk_bf16(v0[2], v0[3]); w.z = cvt_pk_bf16(v1[0], v1[1]); w.w = cvt_pk_bf16(v1[2], v1[3]);
                    *(u32x4*)(rowp + bj * HALF) = w; } }
    }
};
struct EpiSoftmax {
    static constexpr bool PERM = true, AFTER_DRAIN = true;
    bf16_t* P; int ldc;
    __device__ __forceinline__ void fused(f32x4 (&acc)[2][2][4][2], const Unit& u, int wr, int wc, int fr, int fq, PG8_LAS unsigned char* lds, int wid, int lane) const {
        PG8_LAS float* X = (PG8_LAS float*)lds;
        PG8_LAS float* Y = (PG8_LAS float*)(lds + 4096);
#pragma unroll
        for (int ai = 0; ai < 2; ++ai)
#pragma unroll
            for (int m = 0; m < 4; ++m) { float mx = -3.0e38f;
#pragma unroll
                for (int bj = 0; bj < 2; ++bj)
#pragma unroll
                    for (int n = 0; n < 2; ++n) { const f32x4 x = acc[ai][bj][m][n]; mx = fmaxf(mx, fmaxf(fmaxf(x[0], x[1]), fmaxf(x[2], x[3]))); }
                mx = fmaxf(mx, __shfl_xor(mx, 16)); mx = fmaxf(mx, __shfl_xor(mx, 32));
                if (fq == 0) X[(ai * HALF + wr * 64 + m * 16 + fr) * 4 + wc] = mx; }
        asm volatile("s_waitcnt lgkmcnt(0)" ::: "memory"); __builtin_amdgcn_s_barrier(); asm volatile("" ::: "memory");
#pragma unroll
        for (int ai = 0; ai < 2; ++ai)
#pragma unroll
            for (int m = 0; m < 4; ++m) { const int r = ai * HALF + wr * 64 + m * 16 + fr; const f32x4 q = *(const PG8_LAS f32x4*)(X + r * 4);
                const float mx = fmaxf(fmaxf(q[0], q[1]), fmaxf(q[2], q[3])); float s = 0.f;
#pragma unroll
                for (int bj = 0; bj < 2; ++bj)
#pragma unroll
                    for (int n = 0; n < 2; ++n) { f32x4 x = acc[ai][bj][m][n];
#pragma unroll
                        for (int j = 0; j < 4; ++j) { x[j] = __expf(x[j] - mx); s += x[j]; }
                        acc[ai][bj][m][n] = x; }
                s += __shfl_xor(s, 16); s += __shfl_xor(s, 32);
                if (fq == 0) Y[r * 4 + wc] = s; }
        asm volatile("s_waitcnt lgkmcnt(0)" ::: "memory"); __builtin_amdgcn_s_barrier(); asm volatile("" ::: "memory");
        const int row0 = u.pm * BM + wr * 64 + fr, col0 = u.pn * BM + wc * 32 + 8 * fq;
#pragma unroll
        for (int ai = 0; ai < 2; ++ai)
#pragma unroll
            for (int m = 0; m < 4; ++m) { const int r = ai * HALF + wr * 64 + m * 16 + fr; const f32x4 q = *(const PG8_LAS f32x4*)(Y + r * 4);
                const float inv = 1.0f / ((q[0] + q[1]) + (q[2] + q[3]));
                bf16_t* rowp = P + (size_t)(row0 + ai * HALF + m * 16) * ldc + col0;
#pragma unroll
                for (int bj = 0; bj < 2; ++bj) { const f32x4 v0 = acc[ai][bj][m][0] * inv, v1 = acc[ai][bj][m][1] * inv;
                    u32x4 w; w.x = cvt_pk_bf16(v0[0], v0[1]); w.y = cvt_pk_bf16(v0[2], v0[3]); w.z = cvt_pk_bf16(v1[0], v1[1]); w.w = cvt_pk_bf16(v1[2], v1[3]);
                    *(u32x4*)(rowp + bj * HALF) = w; } }
        asm volatile("s_waitcnt lgkmcnt(0)" ::: "memory"); __builtin_amdgcn_s_barrier(); asm volatile("" ::: "memory");
    }
};

template <class Epi, class Sched, bool ALIGN_EPI>
__device__ __forceinline__ void gemm_phase(PG8_LAS unsigned char* lds, const Gemm g, const Sched& S, const Epi& E) {
    const int tid = threadIdx.x, wid = __builtin_amdgcn_readfirstlane(tid >> 6), lane = tid & 63, wr = wid >> 2, wc = wid & 3, fr = lane & 15, fq = lane >> 4;
    const int nt = g.K / BK;
    unsigned voffA[2], voffB[2];
#pragma unroll
    for (int i = 0; i < 2; ++i) { int R, C; stage_rc(tid * 16 + i * 8192, R, C); const int Rb = Epi::PERM ? ((R & ~31) + perm32(R & 31)) : R;
        voffA[i] = (unsigned)(R * g.lda + C) * 2u; voffB[i] = (unsigned)(Rb * g.ldb + C) * 2u; }
    const size_t kstep = (size_t)(BK * 2);
    const size_t hstepA = (size_t)HALF * g.lda * 2, hstepB = (size_t)HALF * g.ldb * 2;
    const unsigned ldsw = (unsigned)wid * 1024u;
    const int aoff = lds_byte(wr * 64 + fr, fq * 8), boff = lds_byte(wc * 32 + fr, fq * 8);
#define PG8_SA(b, h) (((b) * 2 + (h)) * HTB)
#define PG8_SB(b, h) ((4 + (b) * 2 + (h)) * HTB)
#define PG8_STAGE(bufoff, gbase, voff) do { _Pragma("unroll") for (int _i = 0; _i < 2; ++_i) \
        __builtin_amdgcn_global_load_lds((const unsigned*)((const char*)(gbase) + (voff)[_i]), (PG8_LAS unsigned*)(lds + (bufoff) + ldsw + _i * 8192), 16, 0, 0); } while (0)
#define PG8_LDA(dst, b, h) do { _Pragma("unroll") for (int m = 0; m < 4; ++m) _Pragma("unroll") for (int k = 0; k < 2; ++k) dst[m][k] = *(const PG8_LAS bf16x8*)(lds + PG8_SA(b, h) + aoff + m * 2048 + k * 1024); } while (0)
#define PG8_LDB(dst, b, h) do { _Pragma("unroll") for (int n = 0; n < 2; ++n) _Pragma("unroll") for (int k = 0; k < 2; ++k) dst[n][k] = *(const PG8_LAS bf16x8*)(lds + PG8_SB(b, h) + boff + n * 2048 + k * 1024); } while (0)
#define PG8_MMA(ai, bj, At, Bt) do { __builtin_amdgcn_s_setprio(1); _Pragma("unroll") for (int m = 0; m < 4; ++m) _Pragma("unroll") for (int n = 0; n < 2; ++n) _Pragma("unroll") for (int k = 0; k < 2; ++k) \
        acc[ai][bj][m][n] = __builtin_amdgcn_mfma_f32_16x16x32_bf16(Bt[n][k], At[m][k], acc[ai][bj][m][n], 0, 0, 0); __builtin_amdgcn_s_setprio(0); } while (0)
#define PG8_WAIT_V(n) asm volatile("s_waitcnt vmcnt(" #n ")" ::: "memory")
#define PG8_WAIT_L(n) asm volatile("s_waitcnt lgkmcnt(" #n ")" ::: "memory")
#define PG8_BAR __builtin_amdgcn_s_barrier()
#define PG8_SCHED __builtin_amdgcn_sched_barrier(0)
    Unit cur, nxt; int ui = 0;
    if (!S.next(0, cur)) return;
    f32x4 acc[2][2][4][2];
#pragma unroll
    for (int a = 0; a < 2; ++a)
#pragma unroll
        for (int b = 0; b < 2; ++b)
#pragma unroll
            for (int m = 0; m < 4; ++m)
#pragma unroll
                for (int n = 0; n < 2; ++n) acc[a][b][m][n] = (f32x4){0.f, 0.f, 0.f, 0.f};
    bf16x8 At[4][2], B0[2][2], B1[2][2];
    const char* cA = (const char*)g.A + cur.aoff; const char* cB = (const char*)g.Bt + cur.boff;
    PG8_STAGE(PG8_SB(0, 0), cB, voffB); PG8_STAGE(PG8_SB(0, 1), cB + hstepB, voffB); PG8_STAGE(PG8_SA(0, 0), cA, voffA); PG8_STAGE(PG8_SA(0, 1), cA + hstepA, voffA);
    if (wr == 1) PG8_BAR;
    PG8_WAIT_V(2); PG8_BAR;
    PG8_STAGE(PG8_SB(1, 0), cB + kstep, voffB); PG8_STAGE(PG8_SA(1, 0), cA + kstep, voffA); PG8_STAGE(PG8_SB(1, 1), cB + hstepB + kstep, voffB);
    PG8_WAIT_V(6); PG8_BAR;
    for (;;) {
        const bool has_next = S.next(ui + 1, nxt);
        const char* nA = has_next ? (const char*)g.A + nxt.aoff : cA; const char* nB = has_next ? (const char*)g.Bt + nxt.boff : cB;
        for (int t = 0; t < nt; t += 2) {
            const bool last = (t == nt - 2);
            const char* a1 = cA + (size_t)(t + 1) * kstep;
            const char* a2 = last ? nA : cA + (size_t)(t + 2) * kstep; const char* b2 = last ? nB : cB + (size_t)(t + 2) * kstep;
            const char* a3 = a2 + kstep; const char* b3 = b2 + kstep;
            PG8_LDB(B0, 0, 0); PG8_LDB(B1, 0, 1); PG8_SCHED; PG8_LDA(At, 0, 0); PG8_STAGE(PG8_SA(1, 1), a1 + hstepA, voffA);
            PG8_WAIT_V(8); PG8_WAIT_L(0); PG8_BAR; PG8_MMA(0, 0, At, B0); PG8_MMA(0, 1, At, B1); PG8_BAR; PG8_SCHED;
            PG8_LDA(At, 0, 1); PG8_STAGE(PG8_SB(0, 0), b2, voffB); PG8_STAGE(PG8_SB(0, 1), b2 + hstepB, voffB); PG8_STAGE(PG8_SA(0, 0), a2, voffA);
            PG8_WAIT_V(8); PG8_WAIT_L(0); PG8_BAR; PG8_MMA(1, 0, At, B0); PG8_MMA(1, 1, At, B1); PG8_BAR; PG8_SCHED;
            PG8_LDB(B0, 1, 0); PG8_LDB(B1, 1, 1); PG8_SCHED; PG8_LDA(At, 1, 0); PG8_STAGE(PG8_SA(0, 1), a2 + hstepA, voffA);
            PG8_WAIT_V(8); PG8_WAIT_L(0); PG8_BAR; PG8_MMA(0, 0, At, B0); PG8_MMA(0, 1, At, B1); PG8_BAR; PG8_SCHED;
            PG8_LDA(At, 1, 1); PG8_STAGE(PG8_SB(1, 0), b3, voffB); PG8_STAGE(PG8_SB(1, 1), b3 + hstepB, voffB); PG8_STAGE(PG8_SA(1, 0), a3, voffA);
            PG8_WAIT_V(8); PG8_WAIT_L(0); PG8_BAR; PG8_MMA(1, 0, At, B0); PG8_MMA(1, 1, At, B1); PG8_BAR; PG8_SCHED;
        }
        if constexpr (ALIGN_EPI) { if (wr == 0) PG8_BAR; }
        if constexpr (!Epi::AFTER_DRAIN) { E(acc, cur, wr, wc, fr, fq); }
        if (!has_next) break;
#pragma unroll
        for (int a = 0; a < 2; ++a)
#pragma unroll
            for (int b = 0; b < 2; ++b)
#pragma unroll
                for (int m = 0; m < 4; ++m)
#pragma unroll
                    for (int n = 0; n < 2; ++n) acc[a][b][m][n] = (f32x4){0.f, 0.f, 0.f, 0.f};
        cur = nxt; cA = nA; cB = nB; ++ui;
        if constexpr (ALIGN_EPI) { if (wr == 1) PG8_BAR; }
    }
    PG8_WAIT_V(0);
    if constexpr (!ALIGN_EPI) { if (wr == 0) PG8_BAR; }
    PG8_BAR;
    if constexpr (Epi::AFTER_DRAIN) { E.fused(acc, cur, wr, wc, fr, fq, lds, wid, lane); }
#undef PG8_SA
#undef PG8_SB
#undef PG8_STAGE
#undef PG8_LDA
#undef PG8_LDB
#undef PG8_MMA
#undef PG8_WAIT_V
#undef PG8_WAIT_L
#undef PG8_BAR
#undef PG8_SCHED
}
}

#define GAS __attribute__((address_space(1)))
#define LAS __attribute__((address_space(3)))
typedef unsigned v4u __attribute__((ext_vector_type(4)));
typedef float f32x4 __attribute__((ext_vector_type(4)));
typedef short bf16x8 __attribute__((ext_vector_type(8)));
#define LDS_WAIT() asm volatile("s_waitcnt lgkmcnt(0)" ::: "memory")
#define VM_WAIT() asm volatile("s_waitcnt vmcnt(0)" ::: "memory")
#define XB_TMO      128
#define XB_XCNT(j)  (256  + 64 * (j))
#define XB_XSUB(j)  (1280 + 64 * (j))
#define XB_XGEN(j)  (2304 + 64 * (j))
#define XB_TOP      3328
#define XB_TOPGEN   3392
#define XCD_BAR_WORDS 3456
#define XB_SPIN_CAP (1u << 18)

__device__ __forceinline__ unsigned xb_ld(unsigned* p)              { return __hip_atomic_load(p, __ATOMIC_RELAXED, __HIP_MEMORY_SCOPE_AGENT); }
__device__ __forceinline__ unsigned xb_add(unsigned* p, unsigned v) { return __hip_atomic_fetch_add(p, v, __ATOMIC_RELAXED, __HIP_MEMORY_SCOPE_AGENT); }
__device__ __forceinline__ unsigned xb_xcc_id() { return (unsigned)__builtin_amdgcn_s_getreg((3 << 11) | 20) & 0xFu; }
#define XB_SPIN(cond, bar) do { unsigned _sp = 0; while (cond) { __builtin_amdgcn_s_sleep(1); \
    if ((++_sp & 255u) == 0u) { if (xb_ld(&(bar)[XB_TMO])) break; if (_sp > XB_SPIN_CAP) { atomicAdd(&(bar)[XB_TMO], 1u); break; } } } } while (0)

struct XcdBarrier {
    unsigned* bar; unsigned x;
    volatile LAS unsigned* st;
};

__device__ __forceinline__ XcdBarrier xcd_barrier_post(unsigned* bar, volatile LAS unsigned* st) {
    XcdBarrier b; b.bar = bar; b.x = xb_xcc_id(); b.st = st;
    if (threadIdx.x == 0) (void)xb_add(&bar[XB_XCNT(b.x)], 1u);
    return b;
}
__device__ __forceinline__ void xcd_barrier_complete(unsigned* bar, unsigned x, unsigned& nloc, unsigned& nx) {
    const unsigned G = gridDim.x * gridDim.y * gridDim.z;
    unsigned sum, cnt, mine, sp = 0u;
    for (;;) {
        sum = 0u; cnt = 0u; mine = 0u;
#pragma unroll
        for (unsigned j = 0; j < 16; ++j) { const unsigned c = xb_ld(&bar[XB_XCNT(j)]); sum += c; cnt += (c > 0u) ? 1u : 0u; mine = (j == x) ? c : mine; }
        if (sum == G) break;
        __builtin_amdgcn_s_sleep(1);
        if ((++sp & 255u) == 0u) { if (xb_ld(&bar[XB_TMO])) break; if (sp > XB_SPIN_CAP) { atomicAdd(&bar[XB_TMO], 1u); break; } }
    }
    nloc = mine > 0u ? mine : 1u; nx = cnt > 0u ? cnt : 1u;
}

__device__ __forceinline__ void xcd_barrier(const XcdBarrier& b) {
    asm volatile("s_waitcnt vmcnt(0)" ::: "memory");
    __syncthreads();
    if (threadIdx.x == 0) {
        unsigned* bar = b.bar;
        __builtin_amdgcn_s_waitcnt(0);
        unsigned nloc = b.st[0], nx = b.st[1];
        if (nloc == 0u) { xcd_barrier_complete(bar, b.x, nloc, nx); b.st[0] = nloc; b.st[1] = nx; }
        const unsigned old = xb_add(&bar[XB_XSUB(b.x)], 1u);
        const unsigned gen = old / nloc;
        if (old + 1u == (gen + 1u) * nloc) {
            __builtin_amdgcn_fence(__ATOMIC_RELEASE, "agent");
            asm volatile("s_waitcnt vmcnt(0)" ::: "memory");
            const unsigned og = xb_add(&bar[XB_TOP], 1u);
            const unsigned tg = og / nx;
            if (og + 1u == (tg + 1u) * nx) xb_add(&bar[XB_TOPGEN], 1u);
            else XB_SPIN(xb_ld(&bar[XB_TOPGEN]) == tg, bar);
            __builtin_amdgcn_fence(__ATOMIC_ACQUIRE, "agent");
            xb_add(&bar[XB_XGEN(b.x)], 1u);
            asm volatile("s_waitcnt vmcnt(0)" ::: "memory");
        } else {
            XB_SPIN(xb_ld(&bar[XB_XGEN(b.x)]) == gen, bar);
            __builtin_amdgcn_fence(__ATOMIC_ACQUIRE, "agent");
            asm volatile("s_waitcnt vmcnt(0)" ::: "memory");
        }
    }
    __syncthreads();
}
constexpr int NWAVES = 8;
constexpr int M = 16384, D = 1024, FF = 2816, SEQ = 4096, NB = 4;
constexpr int MEMROWS = 1024;
constexpr float LN_EPS = 1e-5f;
constexpr float ALPHA = 1.189207115002721f;
constexpr size_t MiB = 1u << 20;
constexpr size_t WS_CTL = 0, CTL_ZERO_BYTES = 1 * MiB;
constexpr size_t WS_W1GU = 1 * MiB;
constexpr size_t WS_W1D = 12 * MiB;
constexpr size_t WS_WIN = 18 * MiB;
constexpr size_t WS_WOUT = 24 * MiB;
constexpr size_t WS_WQ = 26 * MiB, WS_WK = 28 * MiB, WS_WV = 30 * MiB, WS_WO = 32 * MiB;
constexpr size_t WS_W2GU = 34 * MiB, WS_W2D = 45 * MiB;
constexpr size_t WS_DEC = 50 * MiB + 512 * 1024;
constexpr size_t WS_KB = 51 * MiB, WS_VTB = 53 * MiB, WS_MEMLN = 55 * MiB;
constexpr size_t WS_XN = 57 * MiB;
constexpr size_t WS_HB = 89 * MiB;
constexpr size_t WS_PQ = 89 * MiB, WS_PFZ = 105 * MiB, WS_PG = 137 * MiB, WS_PU = 153 * MiB, WS_IVT = 169 * MiB, WS_VT = 185 * MiB, WS_MIX = 201 * MiB;
constexpr size_t WS_QB = 89 * MiB, WS_PB = 121 * MiB, WS_OB = 153 * MiB;
constexpr size_t WS_END = 256 * MiB;
constexpr int CW_BAR = 4096;
constexpr int RING_OFF = 0, RING_BYTES = 131072;
constexpr int LDSCTL_OFF = RING_BYTES, MISC_OFF = LDSCTL_OFF + 320;
constexpr int LDS_BYTES = 147456;

typedef pg8::bf16_t bf16;
__device__ __forceinline__ float bf2f(bf16 v) { return __uint_as_float((unsigned)v << 16); }
__device__ __forceinline__ unsigned pk2(float lo, float hi) { return pg8::cvt_pk_bf16(lo, hi); }
__device__ __forceinline__ float wave_sum(float v) {
#pragma unroll
    for (int o = 1; o < 64; o <<= 1) v += __shfl_xor(v, o);
    return v;
}
__device__ __forceinline__ void transpose_item(const float* W, int K, int N, int k0, int n0, bf16* dstrow, LAS float* scr, int lane) {
#pragma unroll 8
    for (int i = 0; i < 32; ++i) { const int kk = 2 * i + (lane >> 5); scr[kk * 33 + (lane & 31)] = W[(size_t)(k0 + kk) * N + n0 + (lane & 31)]; }
    LDS_WAIT(); asm volatile("" ::: "memory");
    const int c = lane & 7;
#pragma unroll
    for (int j = 0; j < 4; ++j) { const int n = (lane >> 3) + 8 * j; const LAS float* s = scr + (8 * c) * 33 + n;
        v4u o; o.x = pk2(s[0 * 33], s[1 * 33]); o.y = pk2(s[2 * 33], s[3 * 33]); o.z = pk2(s[4 * 33], s[5 * 33]); o.w = pk2(s[6 * 33], s[7 * 33]);
        *(v4u*)(dstrow + (size_t)n * K + k0 + 8 * c) = o; }
    LDS_WAIT(); asm volatile("" ::: "memory");
}
__device__ __forceinline__ void transpose_matrix_item(const float* W, int K, int N, bf16* WT, int kind, int item, LAS float* scr, int lane) {
    const int nblk = N / 32, kb = item / nblk, nb = item % nblk, k0 = 64 * kb, n0 = 32 * nb;
    int r0 = n0;
    if (kind == 1) r0 = (n0 >> 7) * 256 + (n0 & 127);
    else if (kind == 2) r0 = (n0 >> 7) * 256 + 128 + (n0 & 127);
    else if (kind == 3) { const int seg = n0 >> 9, w = n0 & 511; const int base = seg == 0 ? 0 : seg == 1 ? 512 : seg == 2 ? 2048 : seg == 3 ? 1024 : seg == 4 ? 1536 : 2560; r0 = base + w; }
    transpose_item(W, K, N, k0, n0, WT + (size_t)r0 * K, scr, lane);
}
__device__ __forceinline__ void ln_row(const float* src, float* dstf, bf16* dstb, const float* g, const float* b, int lane) {
    const f32x4* xr = (const f32x4*)src + lane;
    f32x4 v[4]; float s = 0.f;
#pragma unroll
    for (int j = 0; j < 4; ++j) { v[j] = xr[64 * j]; s += (v[j].x + v[j].y) + (v[j].z + v[j].w); }
    const float mean = wave_sum(s) * (1.f / 1024.f); float s2 = 0.f;
#pragma unroll
    for (int j = 0; j < 4; ++j) { v[j] = v[j] - mean; s2 += (v[j].x * v[j].x + v[j].y * v[j].y) + (v[j].z * v[j].z + v[j].w * v[j].w); }
    const float rstd = 1.f / sqrtf(wave_sum(s2) * (1.f / 1024.f) + LN_EPS);
#pragma unroll
    for (int j = 0; j < 4; ++j) { const f32x4 gg = ((const f32x4*)g)[lane + 64 * j], bb = ((const f32x4*)b)[lane + 64 * j];
        const f32x4 o = v[j] * rstd * gg + bb;
        if (dstf) ((f32x4*)dstf)[lane + 64 * j] = o;
        if (dstb) { unsigned long long w = (unsigned long long)pk2(o.x, o.y) | ((unsigned long long)pk2(o.z, o.w) << 32); ((unsigned long long*)dstb)[lane + 64 * j] = w; } }
}


__device__ __forceinline__ void hgrn2_naive(LAS unsigned char* lds, int unit, const bf16* PQ, const float* PFZ, const bf16* IVT, const float* lbl, float* ORAW, int tid, int lane, int wave) {
    const int dvg = unit & 7, h = (unit >> 3) & 3, b = unit >> 5;
    LAS float* qs = (LAS float*)lds; LAS float* fs = qs + 32 * 128; LAS float* ks = fs + 32 * 128; LAS float* vs = ks + 32 * 128; LAS float* os = vs + 32 * 16;
    const int dk = tid & 127, tq = tid >> 7;
    const float l0 = lbl[h * 128 + dk], l1 = lbl[512 + h * 128 + dk];
    const float lb = 1.0f / (1.0f + __expf(l1 - l0));
    const int dkp = lane & 31, dvl = 2 * wave + (lane >> 5);
    float S0 = 0.f, S1 = 0.f, S2 = 0.f, S3 = 0.f;
    const size_t tokb = (size_t)b * SEQ;
    const int vj = tid >> 5, vt = tid & 31;
    bf16 qreg[8]; float zreg[8]; bf16 vreg;
#pragma unroll
    for (int i = 0; i < 8; ++i) { const size_t tok = tokb + (tq + 4 * i); qreg[i] = PQ[tok * 512 + h * 128 + dk]; zreg[i] = PFZ[tok * 512 + h * 128 + dk]; }
    vreg = IVT[(size_t)(h * 128 + dvg * 16 + vj) * M + tokb + vt];
    for (int ch = 0; ch < SEQ / 32; ++ch) {
        const size_t tok0 = tokb + (size_t)ch * 32;
#pragma unroll
        for (int i = 0; i < 8; ++i) { const int t = tq + 4 * i; const float kk = (1.0f - lb) / (1.0f + __expf(zreg[i]));
            qs[t * 128 + dk] = bf2f(qreg[i]); ks[t * 128 + dk] = kk; fs[t * 128 + dk] = 1.0f - kk; }
        vs[vt * 16 + vj] = bf2f(vreg);
        __syncthreads();
        if (ch + 1 < SEQ / 32) {
#pragma unroll
            for (int i = 0; i < 8; ++i) { const size_t tok = tok0 + 32 + (tq + 4 * i); qreg[i] = PQ[tok * 512 + h * 128 + dk]; zreg[i] = PFZ[tok * 512 + h * 128 + dk]; }
            vreg = IVT[(size_t)(h * 128 + dvg * 16 + vj) * M + tok0 + 32 + vt];
        }
        for (int t = 0; t < 32; ++t) {
            const f32x4 q4 = *(const LAS f32x4*)(qs + t * 128 + 4 * dkp), f4 = *(const LAS f32x4*)(fs + t * 128 + 4 * dkp), k4 = *(const LAS f32x4*)(ks + t * 128 + 4 * dkp);
            const float v = vs[t * 16 + dvl];
            S0 = f4.x * S0 + k4.x * v; S1 = f4.y * S1 + k4.y * v; S2 = f4.z * S2 + k4.z * v; S3 = f4.w * S3 + k4.w * v;
            float p = (q4.x * S0 + q4.y * S1) + (q4.z * S2 + q4.w * S3);
            p += __shfl_xor(p, 16); p += __shfl_xor(p, 8); p += __shfl_xor(p, 4); p += __shfl_xor(p, 2); p += __shfl_xor(p, 1);
            if (dkp == 0) os[t * 16 + dvl] = p;
        }
        __syncthreads();
        { const int t = tid >> 4, j = tid & 15; ORAW[(tok0 + t) * 512 + h * 128 + dvg * 16 + j] = os[t * 16 + j]; }
        __syncthreads();
    }
}
__device__ __forceinline__ void sgu_naive(LAS unsigned char* lds, int unit, const bf16* VT, const bf16* PU, const float* lng, const float* lnb, const float* Ws, const float* bs, bf16* MIX, int tid) {
    const int g = unit & 3, n = (unit >> 2) & 31, b = unit >> 7;
    const size_t tok0 = (size_t)b * SEQ + (size_t)n * 128;
    LAS float* vn = (LAS float*)lds;
    LAS float* mu = vn + 128 * 129; LAS float* rs = mu + 128;
#pragma unroll 4
    for (int i = 0; i < 32; ++i) { const int idx = tid + 512 * i, s = idx & 127, c = idx >> 7; vn[s * 129 + c] = bf2f(VT[(size_t)(g * 128 + c) * M + tok0 + s]); }
    __syncthreads();
    if (tid < 128) { const int s = tid; float sum = 0.f;
        for (int c = 0; c < 128; ++c) sum += vn[s * 129 + c];
        const float mean = sum * (1.f / 128.f); float sq = 0.f;
        for (int c = 0; c < 128; ++c) { const float d = vn[s * 129 + c] - mean; sq += d * d; }
        mu[s] = mean; rs[s] = 1.f / sqrtf(sq * (1.f / 128.f) + LN_EPS); }
    __syncthreads();
    { const int c = tid & 127; const float gg = lng[g * 128 + c], bb = lnb[g * 128 + c];
#pragma unroll 4
      for (int i = 0; i < 32; ++i) { const int s = (tid >> 7) + 4 * i; vn[s * 129 + c] = (vn[s * 129 + c] - mu[s]) * rs[s] * gg + bb; } }
    __syncthreads();
    { const int c = tid & 127; const int tq = __builtin_amdgcn_readfirstlane(tid >> 7);
      for (int i = 0; i < 32; ++i) { const int t = 4 * i + tq; const float* wrow = Ws + (size_t)(g * 128 + t) * 128; float acc = 0.f;
          for (int s = 0; s <= t; ++s) acc += wrow[s] * vn[s * 129 + c];
          const float so = acc + bs[g * 128 + t];
          const float uu = bf2f(PU[(tok0 + t) * 512 + g * 128 + c]);
          const unsigned w = pk2(uu * so, 0.f);
          MIX[(tok0 + t) * D + 512 + g * 128 + c] = (bf16)(w & 0xffffu); } }
    __syncthreads();
}

constexpr int HP = 136;
constexpr int SPP = 72;
__device__ __forceinline__ bf16 f2bf1(float x) { return (bf16)(pk2(x, 0.f) & 0xffffu); }

__device__ __forceinline__ void hg_passA(LAS unsigned char* lds, int u, const float* PFZ, const bf16* IVT, const float* lbl, bf16* AT, float* DEC, int tid, int lane, int wave) {
    const int n = u & 63, bh = u >> 6, b = bh >> 2, h = bh & 3;
    const size_t tok0 = (size_t)b * SEQ + (size_t)n * 64;
    LAS bf16* KP = (LAS bf16*)lds;
    LAS float* TOT = (LAS float*)(lds + 128 * SPP * 2);
    const int dk = tid & 127, J = tid >> 7, fr = lane & 15, fq = lane >> 4;
    bf16x8 bV[2];
#pragma unroll
    for (int k2 = 0; k2 < 2; ++k2) bV[k2] = *(const bf16x8*)(IVT + (size_t)(h * 128 + 16 * wave + fr) * M + tok0 + 32 * k2 + 8 * fq);
    const float l0 = lbl[h * 128 + dk], l1 = lbl[512 + h * 128 + dk];
    const float lb = 1.0f / (1.0f + __expf(l1 - l0));
    float bl[16], kk[16]; float run = 0.f;
#pragma unroll
    for (int i = 0; i < 16; ++i) { const float fz = PFZ[(tok0 + 16 * J + i) * 512 + h * 128 + dk]; const float k = (1.0f - lb) / (1.0f + __expf(fz)); kk[i] = k; run += __logf(1.0f - k); bl[i] = run; }
    TOT[J * 128 + dk] = run;
    __syncthreads();
    const float t0 = TOT[dk], t1 = TOT[128 + dk], t2 = TOT[256 + dk], t3 = TOT[384 + dk];
    const float suf = (J < 1 ? t1 : 0.f) + (J < 2 ? t2 : 0.f) + (J < 3 ? t3 : 0.f);
    const float top = run + suf;
    unsigned w[8];
#pragma unroll
    for (int i = 0; i < 8; ++i) w[i] = pk2(kk[2 * i] * __expf(top - bl[2 * i]), kk[2 * i + 1] * __expf(top - bl[2 * i + 1]));
    *(LAS v4u*)(KP + dk * SPP + 16 * J) = (v4u){w[0], w[1], w[2], w[3]};
    *(LAS v4u*)(KP + dk * SPP + 16 * J + 8) = (v4u){w[4], w[5], w[6], w[7]};
    if (J == 0) DEC[(size_t)u * 128 + dk] = __expf((t0 + t1) + (t2 + t3));
    __syncthreads();
#pragma unroll
    for (int dkb = 0; dkb < 8; ++dkb) { f32x4 acc = (f32x4){0.f, 0.f, 0.f, 0.f};
#pragma unroll
        for (int k2 = 0; k2 < 2; ++k2) { const bf16x8 a = *(const LAS bf16x8*)(KP + (dkb * 16 + fr) * SPP + 32 * k2 + 8 * fq); acc = __builtin_amdgcn_mfma_f32_16x16x32_bf16(a, bV[k2], acc, 0, 0, 0); }
        unsigned long long o = (unsigned long long)pk2(acc[0], acc[1]) | ((unsigned long long)pk2(acc[2], acc[3]) << 32);
        *(unsigned long long*)(AT + ((size_t)u * 128 + 16 * wave + fr) * 128 + dkb * 16 + 4 * fq) = o; }
    __syncthreads();
}
__device__ __forceinline__ void hg_scan(bf16* AT, const float* DEC, int gid) {
    const int bh = gid >> 13, p = gid & 8191, dv = p >> 6, dk = (p & 63) * 2;
    unsigned* base = (unsigned*)(AT + ((size_t)(bh * 64) * 128 + dv) * 128 + dk);
    const float* dbase = DEC + (size_t)(bh * 64) * 128 + dk;
    float s0 = 0.f, s1 = 0.f;
    for (int n0 = 0; n0 < 64; n0 += 8) {
        unsigned a[8]; float d0[8], d1[8];
#pragma unroll
        for (int j = 0; j < 8; ++j) { a[j] = base[(size_t)(n0 + j) * 8192]; d0[j] = dbase[(n0 + j) * 128]; d1[j] = dbase[(n0 + j) * 128 + 1]; }
        asm volatile("s_waitcnt vmcnt(0)" ::: "memory");
#pragma unroll
        for (int j = 0; j < 8; ++j) { base[(size_t)(n0 + j) * 8192] = pk2(s0, s1); s0 = d0[j] * s0 + __uint_as_float(a[j] << 16); s1 = d1[j] * s1 + __uint_as_float(a[j] & 0xffff0000u); }
    }
}
__device__ __forceinline__ void hg_passC(LAS unsigned char* lds, int u, const bf16* PQ, const float* PFZ, const bf16* PG, const bf16* IVT, const float* lbl, const bf16* ST, const float* ng, bf16* MIX, int tid, int lane, int wave) {
    const int n = u & 63, bh = u >> 6, b = bh >> 2, h = bh & 3;
    const size_t tok0 = (size_t)b * SEQ + (size_t)n * 64;
    LAS bf16* QT = (LAS bf16*)lds;
    LAS bf16* QP = QT + 64 * HP;
    LAS bf16* KT = QP + 64 * HP;
    LAS bf16* PS = KT + 160 * HP;
    LAS float* TOT = (LAS float*)(PS + 64 * SPP);
    LAS float* OBUF = (LAS float*)KT;
    const int dk = tid & 127, J = tid >> 7, fr = lane & 15, fq = lane >> 4;
    bf16x8 aV[2], aS[4];
#pragma unroll
    for (int k2 = 0; k2 < 2; ++k2) aV[k2] = *(const bf16x8*)(IVT + (size_t)(h * 128 + 16 * wave + fr) * M + tok0 + 32 * k2 + 8 * fq);
#pragma unroll
    for (int k2 = 0; k2 < 4; ++k2) aS[k2] = *(const bf16x8*)(ST + ((size_t)u * 128 + 16 * wave + fr) * 128 + 32 * k2 + 8 * fq);
    const float l0 = lbl[h * 128 + dk], l1 = lbl[512 + h * 128 + dk];
    const float lb = 1.0f / (1.0f + __expf(l1 - l0));
    float bl[16], kk[16], qv[16]; float run = 0.f;
#pragma unroll
    for (int i = 0; i < 16; ++i) { const size_t e = (tok0 + 16 * J + i) * 512 + h * 128 + dk; const float fz = PFZ[e]; qv[i] = bf2f(PQ[e]);
        const float k = (1.0f - lb) / (1.0f + __expf(fz)); kk[i] = k; run += __logf(1.0f - k); bl[i] = run; }
    TOT[J * 128 + dk] = run;
    __syncthreads();
    const float t0 = TOT[dk], t1 = TOT[128 + dk], t2 = TOT[256 + dk];
    const float pre = (J > 0 ? t0 : 0.f) + (J > 1 ? t1 : 0.f) + (J > 2 ? t2 : 0.f);
    const float epre = __expf(pre);
    const float m1 = J == 0 ? t1 : (J == 1 ? t2 : 0.f);
    const float m2 = J == 0 ? t2 : 0.f;
    const float F2 = __expf(m1), F3 = __expf(m1 + m2);
    const int roffJ = J == 0 ? 0 : (J == 1 ? 16 : (J == 2 ? 48 : 96));
#pragma unroll
    for (int i = 0; i < 16; ++i) {
        const int t = 16 * J + i;
        const float qt = qv[i] * __expf(bl[i]);
        QT[t * HP + dk] = f2bf1(qt); QP[t * HP + dk] = f2bf1(qt * epre);
        const float e1 = kk[i] * __expf(run - bl[i]);
        KT[(roffJ + t) * HP + dk] = f2bf1(kk[i] * __expf(-bl[i]));
        if (J <= 2) KT[((J == 0 ? 16 : (J == 1 ? 48 : 96)) + t) * HP + dk] = f2bf1(e1);
        if (J <= 1) KT[((J == 0 ? 48 : 96) + t) * HP + dk] = f2bf1(e1 * F2);
        if (J == 0) KT[(96 + t) * HP + dk] = f2bf1(e1 * F3);
    }
    __syncthreads();
#pragma unroll
    for (int rep = 0; rep < 2; ++rep) {
        const int idx = wave + 8 * rep;
        if (idx < 10) {
            const int I = idx >= 6 ? 3 : (idx >= 3 ? 2 : (idx >= 1 ? 1 : 0)); const int Jb = idx - (I * (I + 1)) / 2;
            const int roffI = I == 0 ? 0 : (I == 1 ? 16 : (I == 2 ? 48 : 96));
            f32x4 acc = (f32x4){0.f, 0.f, 0.f, 0.f};
#pragma unroll
            for (int k2 = 0; k2 < 4; ++k2) { const bf16x8 a = *(const LAS bf16x8*)(KT + (roffI + 16 * Jb + fr) * HP + 32 * k2 + 8 * fq);
                const bf16x8 bq = *(const LAS bf16x8*)(QT + (16 * I + fr) * HP + 32 * k2 + 8 * fq);
                acc = __builtin_amdgcn_mfma_f32_16x16x32_bf16(a, bq, acc, 0, 0, 0); }
            const int t = 16 * I + fr, s0 = 16 * Jb + 4 * fq;
            const float v0 = s0 <= t ? acc[0] : 0.f, v1 = s0 + 1 <= t ? acc[1] : 0.f, v2 = s0 + 2 <= t ? acc[2] : 0.f, v3 = s0 + 3 <= t ? acc[3] : 0.f;
            *(LAS unsigned long long*)(PS + t * SPP + s0) = (unsigned long long)pk2(v0, v1) | ((unsigned long long)pk2(v2, v3) << 32);
        } else if (idx < 12) {
            const int I = idx == 10 ? 0 : 2, Jb = idx == 10 ? 1 : 3;
            *(LAS unsigned long long*)(PS + (16 * I + fr) * SPP + 16 * Jb + 4 * fq) = 0ull;
        }
    }
    __syncthreads();
#pragma unroll
    for (int I = 0; I < 4; ++I) { f32x4 acc = (f32x4){0.f, 0.f, 0.f, 0.f};
#pragma unroll
        for (int k2 = 0; k2 < 4; ++k2) { const bf16x8 bq = *(const LAS bf16x8*)(QP + (16 * I + fr) * HP + 32 * k2 + 8 * fq); acc = __builtin_amdgcn_mfma_f32_16x16x32_bf16(aS[k2], bq, acc, 0, 0, 0); }
#pragma unroll
        for (int k2 = 0; k2 < 2; ++k2) if (32 * k2 < 16 * (I + 1)) { const bf16x8 bp = *(const LAS bf16x8*)(PS + (16 * I + fr) * SPP + 32 * k2 + 8 * fq); acc = __builtin_amdgcn_mfma_f32_16x16x32_bf16(aV[k2], bp, acc, 0, 0, 0); }
        *(LAS f32x4*)(OBUF + (16 * I + fr) * 132 + 16 * wave + 4 * fq) = acc; }
    __syncthreads();
    { const int t = tid >> 3, c8 = tid & 7;
      f32x4 o[4];
#pragma unroll
      for (int j = 0; j < 4; ++j) o[j] = *(const LAS f32x4*)(OBUF + t * 132 + 16 * c8 + 4 * j);
      float ss = 0.f;
#pragma unroll
      for (int j = 0; j < 4; ++j) ss += (o[j].x * o[j].x + o[j].y * o[j].y) + (o[j].z * o[j].z + o[j].w * o[j].w);
      ss += __shfl_xor(ss, 1); ss += __shfl_xor(ss, 2); ss += __shfl_xor(ss, 4);
      const float rs = 1.f / sqrtf(ss * (1.f / 128.f) + LN_EPS);
      const size_t tok = tok0 + t;
#pragma unroll
      for (int hh = 0; hh < 2; ++hh) {
          const v4u gq = *(const v4u*)(PG + tok * 512 + h * 128 + 16 * c8 + 8 * hh);
          const f32x4 g0 = *(const f32x4*)(ng + 16 * c8 + 8 * hh), g1 = *(const f32x4*)(ng + 16 * c8 + 8 * hh + 4);
          const f32x4 a = o[2 * hh], bb = o[2 * hh + 1];
          v4u w;
          w.x = pk2(a.x * rs * g0.x * __uint_as_float(gq.x << 16), a.y * rs * g0.y * __uint_as_float(gq.x & 0xffff0000u));
          w.y = pk2(a.z * rs * g0.z * __uint_as_float(gq.y << 16), a.w * rs * g0.w * __uint_as_float(gq.y & 0xffff0000u));
          w.z = pk2(bb.x * rs * g1.x * __uint_as_float(gq.z << 16), bb.y * rs * g1.y * __uint_as_float(gq.z & 0xffff0000u));
          w.w = pk2(bb.z * rs * g1.z * __uint_as_float(gq.w << 16), bb.w * rs * g1.w * __uint_as_float(gq.w & 0xffff0000u));
          *(v4u*)(MIX + tok * D + h * 128 + 16 * c8 + 8 * hh) = w; } }
    __syncthreads();
}
struct Args { const float* in[30]; float* out; unsigned char* ws; int ph_lo, ph_hi, li, pad; };
constexpr int N_PHASES = 18;

__global__ void __launch_bounds__(NWAVES * 64, 2) mk_fwd(Args args) {
    extern __shared__ __attribute__((aligned(16))) unsigned char lds_raw[];
    LAS unsigned char* lds = (LAS unsigned char*)lds_raw;
    volatile LAS unsigned* MISC = (volatile LAS unsigned*)(lds + MISC_OFF);
    const int tid = threadIdx.x, lane = tid & 63, wave = __builtin_amdgcn_readfirstlane(tid >> 6);
    const int G = gridDim.x, bx = blockIdx.x;
    const int vcu = (G % 8 == 0) ? (bx % 8) * (G / 8) + bx / 8 : bx;
    unsigned char* ws = args.ws;
    unsigned* ctl = (unsigned*)(ws + WS_CTL);
    for (int u = tid; u < (LDS_BYTES - LDSCTL_OFF) / 4; u += NWAVES * 64) ((LAS unsigned*)(lds + LDSCTL_OFF))[u] = 0u;
    __syncthreads();
    XcdBarrier bar; bar.bar = ctl + CW_BAR + args.li * XCD_BAR_WORDS; bar.x = 0; bar.st = nullptr;
    const int lo = args.ph_lo, hi = args.ph_hi;
    if (hi - lo > 1) bar = xcd_barrier_post(ctl + CW_BAR + args.li * XCD_BAR_WORDS, MISC + 8);
#define IN(k) (lo <= (k) && (k) < hi)
#define SEAM(k) do { if (IN(k) && IN((k) + 1)) xcd_barrier(bar); } while (0)
    const float* x = args.in[0];
    float* out = args.out;
    bf16* W1GU = (bf16*)(ws + WS_W1GU); bf16* W1D = (bf16*)(ws + WS_W1D); bf16* WIN = (bf16*)(ws + WS_WIN); bf16* WOUT = (bf16*)(ws + WS_WOUT);
    bf16* WQ = (bf16*)(ws + WS_WQ); bf16* WK = (bf16*)(ws + WS_WK); bf16* WV = (bf16*)(ws + WS_WV); bf16* WO = (bf16*)(ws + WS_WO);
    bf16* W2GU = (bf16*)(ws + WS_W2GU); bf16* W2D = (bf16*)(ws + WS_W2D);
    bf16* KB = (bf16*)(ws + WS_KB); bf16* VTB = (bf16*)(ws + WS_VTB); bf16* MEMLN = (bf16*)(ws + WS_MEMLN);
    bf16* XN = (bf16*)(ws + WS_XN); bf16* AT = (bf16*)(ws + WS_XN); float* DEC = (float*)(ws + WS_DEC); bf16* HB = (bf16*)(ws + WS_HB);
    bf16* PQ = (bf16*)(ws + WS_PQ); float* PFZ = (float*)(ws + WS_PFZ); bf16* PG = (bf16*)(ws + WS_PG); bf16* PU = (bf16*)(ws + WS_PU);
    bf16* IVT = (bf16*)(ws + WS_IVT); bf16* VT = (bf16*)(ws + WS_VT); bf16* MIX = (bf16*)(ws + WS_MIX);
    bf16* QB = (bf16*)(ws + WS_QB); bf16* PB = (bf16*)(ws + WS_PB); bf16* OB = (bf16*)(ws + WS_OB);
    const int gw = vcu * NWAVES + wave, NGW = G * NWAVES;

    if (IN(0)) {
        LAS float* scr = (LAS float*)(lds + RING_OFF + wave * 16384);
        constexpr int I_GU = (D / 64) * (FF / 32), I_DN = (FF / 64) * (D / 32), I_IN = (D / 64) * (3072 / 32), I_SQ = (D / 64) * (D / 32);
        constexpr int NITEMS = 4 * I_GU + 2 * I_DN + I_IN + 5 * I_SQ;
        for (int it = gw; it < NITEMS; it += NGW) {
            int r = it;
            if (r < I_GU) { transpose_matrix_item(args.in[2], D, FF, W1GU, 1, r, scr, lane); continue; } r -= I_GU;
            if (r < I_GU) { transpose_matrix_item(args.in[3], D, FF, W1GU, 2, r, scr, lane); continue; } r -= I_GU;
            if (r < I_DN) { transpose_matrix_item(args.in[4], FF, D, W1D, 0, r, scr, lane); continue; } r -= I_DN;
            if (r < I_IN) { transpose_matrix_item(args.in[7], D, 3072, WIN, 3, r, scr, lane); continue; } r -= I_IN;
            if (r < I_SQ) { transpose_matrix_item(args.in[14], D, D, WOUT, 0, r, scr, lane); continue; } r -= I_SQ;
            if (r < I_SQ) { transpose_matrix_item(args.in[19], D, D, WQ, 0, r, scr, lane); continue; } r -= I_SQ;
            if (r < I_SQ) { transpose_matrix_item(args.in[20], D, D, WK, 0, r, scr, lane); continue; } r -= I_SQ;
            if (r < I_SQ) { transpose_matrix_item(args.in[21], D, D, WV, 0, r, scr, lane); continue; } r -= I_SQ;
            if (r < I_SQ) { transpose_matrix_item(args.in[22], D, D, WO, 0, r, scr, lane); continue; } r -= I_SQ;
            if (r < I_GU) { transpose_matrix_item(args.in[25], D, FF, W2GU, 1, r, scr, lane); continue; } r -= I_GU;
            if (r < I_GU) { transpose_matrix_item(args.in[26], D, FF, W2GU, 2, r, scr, lane); continue; } r -= I_GU;
            transpose_matrix_item(args.in[27], FF, D, W2D, 0, r, scr, lane);
        }
        for (size_t i = (size_t)(vcu * 512 + tid); i < (size_t)M * D / 8; i += (size_t)G * 512) {
            const f32x4 a = ((const f32x4*)x)[2 * i], b = ((const f32x4*)x)[2 * i + 1];
            v4u o; o.x = pk2(a.x, a.y); o.y = pk2(a.z, a.w); o.z = pk2(b.x, b.y); o.w = pk2(b.z, b.w);
            ((v4u*)XN)[i] = o; }
        for (int m = gw; m < MEMROWS; m += NGW) ln_row(args.in[1] + (size_t)m * D, nullptr, MEMLN + (size_t)m * D, args.in[17], args.in[18], lane);
    }
    SEAM(0);
    if (IN(1)) {
        { pg8::Gemm g{XN, W1GU, D, D, D}; pg8::GridOrder S; S.init(M, 2 * FF, D, D, G, bx); pg8::EpiSwiglu E{HB, FF};
          pg8::gemm_phase<pg8::EpiSwiglu, pg8::GridOrder, true>(lds + RING_OFF, g, S, E); }
        { pg8::Gemm g{MEMLN, WK, D, D, D}; pg8::SmallOrder S; S.init(MEMROWS, D, D, D, bx - 128); pg8::EpiBf16<0> E{KB, D, 1.0f};
          pg8::gemm_phase<pg8::EpiBf16<0>, pg8::SmallOrder, true>(lds + RING_OFF, g, S, E); }
        { pg8::Gemm g{WV, MEMLN, D, D, D}; pg8::SmallOrder S; S.init(D, MEMROWS, D, D, bx - 144); pg8::EpiBf16<0> E{VTB, MEMROWS, 1.0f};
          pg8::gemm_phase<pg8::EpiBf16<0>, pg8::SmallOrder, true>(lds + RING_OFF, g, S, E); }
    }
    SEAM(1);
    if (IN(2)) {
        pg8::Gemm g{HB, W1D, FF, FF, FF}; pg8::GridOrder S; S.init(M, D, FF, FF, G, bx); pg8::EpiResid E{x, out, ALPHA, 0.5f};
        pg8::gemm_phase<pg8::EpiResid, pg8::GridOrder, true>(lds + RING_OFF, g, S, E);
    }
    SEAM(2);
    if (IN(3)) { for (int m = gw; m < M; m += NGW) ln_row(out + (size_t)m * D, out + (size_t)m * D, XN + (size_t)m * D, args.in[5], args.in[6], lane); }
    SEAM(3);
    if (IN(4)) {
        { pg8::Gemm g{XN, WIN, D, D, D}; pg8::GridOrder S; S.init(M, 2048, D, D, G, bx); typedef pg8::EpiProj<(long)((WS_PG - WS_PQ) / 2), (long)((WS_PU - WS_PQ) / 2)> EP; EP E{PQ, PFZ};
          pg8::gemm_phase<EP, pg8::GridOrder, true>(lds + RING_OFF, g, S, E); }
        { pg8::Gemm g{WIN + (size_t)2048 * D, XN, D, D, D}; pg8::GridOrder S; S.init(1024, M, D, D, G, bx); typedef pg8::EpiProjT<(long)((WS_VT - WS_IVT) / 2)> EPT; EPT E{IVT, M};
          pg8::gemm_phase<EPT, pg8::GridOrder, true>(lds + RING_OFF, g, S, E); }
    }
    SEAM(4);
    if (IN(5)) {
        for (int i = 0; i < 4; ++i) hg_passA(lds, vcu * 4 + i, PFZ, IVT, args.in[8], AT, DEC, tid, lane, wave);
        for (int u = bx; u < 512; u += G) sgu_naive(lds, u, VT, PU, args.in[10], args.in[11], args.in[12], args.in[13], MIX, tid);
    }
    SEAM(5);
    if (IN(6)) { for (int gid = bx * 512 + tid; gid < 131072; gid += G * 512) hg_scan(AT, DEC, gid); }
    SEAM(6);
    if (IN(7)) { for (int i = 0; i < 4; ++i) hg_passC(lds, vcu * 4 + i, PQ, PFZ, PG, IVT, args.in[8], AT, args.in[9], MIX, tid, lane, wave); }
    SEAM(7);
    if (IN(8)) {
        pg8::Gemm g{MIX, WOUT, D, D, D}; pg8::GridOrder S; S.init(M, D, D, D, G, bx); pg8::EpiResid E{out, out, ALPHA, 1.0f};
        pg8::gemm_phase<pg8::EpiResid, pg8::GridOrder, true>(lds + RING_OFF, g, S, E);
    }
    SEAM(8);
    if (IN(9)) { for (int m = gw; m < M; m += NGW) ln_row(out + (size_t)m * D, out + (size_t)m * D, XN + (size_t)m * D, args.in[15], args.in[16], lane); }
    SEAM(9);
    if (IN(10)) {
        pg8::Gemm g{XN, WQ, D, D, D}; pg8::GridOrder S; S.init(M, D, D, D, G, bx); pg8::EpiBf16<0> E{QB, D, 0.0625f};
        pg8::gemm_phase<pg8::EpiBf16<0>, pg8::GridOrder, true>(lds + RING_OFF, g, S, E);
    }
    SEAM(10);
    if (IN(11)) {
        pg8::Gemm g{QB, KB, D, D, 256}; pg8::AttnOrder S{bx, 0}; pg8::EpiSoftmax E{PB, D};
        pg8::gemm_phase<pg8::EpiSoftmax, pg8::AttnOrder, false>(lds + RING_OFF, g, S, E);
    }
    SEAM(11);
    if (IN(12)) {
        pg8::Gemm g{PB, VTB, D, MEMROWS, 256}; pg8::AttnOrder S{bx, 1}; pg8::EpiBf16<0> E{OB, D, 1.0f};
        pg8::gemm_phase<pg8::EpiBf16<0>, pg8::AttnOrder, true>(lds + RING_OFF, g, S, E);
    }
    SEAM(12);
    if (IN(13)) {
        pg8::Gemm g{OB, WO, D, D, D}; pg8::GridOrder S; S.init(M, D, D, D, G, bx); pg8::EpiResid E{out, out, ALPHA, 1.0f};
        pg8::gemm_phase<pg8::EpiResid, pg8::GridOrder, true>(lds + RING_OFF, g, S, E);
    }
    SEAM(13);
    if (IN(14)) { for (int m = gw; m < M; m += NGW) ln_row(out + (size_t)m * D, out + (size_t)m * D, XN + (size_t)m * D, args.in[23], args.in[24], lane); }
    SEAM(14);
    if (IN(15)) {
        pg8::Gemm g{XN, W2GU, D, D, D}; pg8::GridOrder S; S.init(M, 2 * FF, D, D, G, bx); pg8::EpiSwiglu E{HB, FF};
        pg8::gemm_phase<pg8::EpiSwiglu, pg8::GridOrder, true>(lds + RING_OFF, g, S, E);
    }
    SEAM(15);
    if (IN(16)) {
        pg8::Gemm g{HB, W2D, FF, FF, FF}; pg8::GridOrder S; S.init(M, D, FF, FF, G, bx); pg8::EpiResid E{out, out, ALPHA, 0.5f};
        pg8::gemm_phase<pg8::EpiResid, pg8::GridOrder, true>(lds + RING_OFF, g, S, E);
    }
    SEAM(16);
    if (IN(17)) { for (int m = gw; m < M; m += NGW) ln_row(out + (size_t)m * D, out + (size_t)m * D, nullptr, args.in[28], args.in[29], lane); }
#undef IN
#undef SEAM
}

#ifndef MK_N_LAUNCHES
#define MK_N_LAUNCHES 1
#endif
extern "C" void kernel_launch(void* const* d_in, const int* in_sizes, int n_in, void* d_out, int out_size, void* d_ws, size_t ws_size, hipStream_t stream) {
    static int grid = 0;
    if (grid == 0) {
        if (n_in != 30 || out_size != M * D || ws_size < WS_END) { fprintf(stderr, "kernel_launch: unexpected shapes (n_in %d, out %d, ws %zu)\n", n_in, out_size, ws_size); grid = -1; return; }
        int dev = 0, cus = 0;
        if (hipGetDevice(&dev) != hipSuccess || hipDeviceGetAttribute(&cus, hipDeviceAttributeMultiprocessorCount, dev) != hipSuccess) { grid = -1; return; }
        if (hipFuncSetAttribute((const void*)mk_fwd, hipFuncAttributeMaxDynamicSharedMemorySize, LDS_BYTES) != hipSuccess) { fprintf(stderr, "kernel_launch: hipFuncSetAttribute failed\n"); grid = -1; return; }
        int per_cu = 0;
        (void)hipOccupancyMaxActiveBlocksPerMultiprocessor(&per_cu, (const void*)mk_fwd, NWAVES * 64, LDS_BYTES);
        (void)hipGetLastError();
        grid = cus;
        if (grid != 256) fprintf(stderr, "kernel_launch: %d CUs (built for 256)\n", grid);
    }
    if (grid < 0) return;
    (void)hipMemsetAsync((char*)d_ws + WS_CTL, 0, CTL_ZERO_BYTES, stream);
    Args a{};
    for (int i = 0; i < 30; ++i) a.in[i] = (const float*)d_in[i];
    a.out = (float*)d_out; a.ws = (unsigned char*)d_ws;
    if (MK_N_LAUNCHES == 1) {
        a.ph_lo = 0; a.ph_hi = N_PHASES; a.li = 0;
        hipLaunchKernelGGL(mk_fwd, dim3(grid), dim3(NWAVES * 64), LDS_BYTES, stream, a);
    } else {
        for (int p = 0; p < N_PHASES; ++p) { a.ph_lo = p; a.ph_hi = p + 1; a.li = 0; hipLaunchKernelGGL(mk_fwd, dim3(grid), dim3(NWAVES * 64), LDS_BYTES, stream, a); }
    }
}
```
